# Optimizing an MI355X kernel written in HIP

```python
import jax, jax.numpy as jnp
from jax import lax
import numpy as np


D_MODEL = 1024
BATCH = 8
SEQ = 8192
DEPTH = 4

CTX_LEN = 256
GRID_W = 64
N_MIXERS = 3
N_SGU_LAYERS = (DEPTH + 2) // 3
N_RWKV_LAYERS = (DEPTH + 1) // 3
N_MLA_LAYERS = DEPTH // 3
RMS_EPS = 1e-6
SGU_WIDTH = 2 * D_MODEL
SGU_CHUNK = 128
SGU_GROUPS = 8
SGU_GROUP_W = SGU_WIDTH // SGU_GROUPS
RWKV_HEAD = 64
RWKV_WIDTH = D_MODEL
RWKV_HEADS = RWKV_WIDTH // RWKV_HEAD
RWKV_DECAY_LORA = 64
RWKV_ICLR_LORA = 64
RWKV_LN_EPS = 64e-5
RWKV_N_LERP = 6
MLA_HEADS = 16
MLA_NOPE = 128
MLA_ROPE = 64
MLA_QK_DIM = MLA_NOPE + MLA_ROPE
MLA_VDIM = 128
MLA_Q_RANK = 768
MLA_KV_RANK = 256
MLA_WIDTH = MLA_HEADS * MLA_VDIM
MLA_QBLOCK = 128
MLA_SCALE = MLA_QK_DIM ** -0.5
ROPE_BASE = 10000.0
ROPE_FREQS_PER_AXIS = MLA_ROPE // 4

kernel_name = 'hybrid_sgu_rwkv7_mla_dit_trunk'


def rms_norm(t, gain=None):
    tf = t.astype(jnp.float32)
    y = tf * lax.rsqrt(jnp.mean(tf * tf, axis=-1, keepdims=True) + RMS_EPS)
    if gain is not None:
        y = y * gain.astype(jnp.float32)
    return y.astype(t.dtype)


def ada_modulation(cond, w, b):
    m = jax.nn.silu(cond) @ w + b
    shift, scale, gate = jnp.split(m, 3, axis=-1)
    return shift[..., None, :], scale[..., None, :], gate[..., None, :]


def sgu_mixer(h, w_in, gain, w_s, b_s, w_out):
    bsz, length, _ = h.shape
    u, v, z = jnp.split(h @ w_in, 3, axis=-1)
    u = jax.nn.gelu(u)
    v = rms_norm(jax.nn.gelu(v), gain)
    vc = v.reshape(bsz, length // SGU_CHUNK, SGU_CHUNK, SGU_GROUPS, SGU_GROUP_W)
    mixed = jnp.einsum('gpq,bcqgd->bcpgd', w_s, vc) + b_s.T[:, :, None]
    s = u * mixed.reshape(bsz, length, SGU_WIDTH)
    return (s * jax.nn.silu(z)) @ w_out


def split_heads(t):
    return t.reshape(t.shape[:-1] + (RWKV_HEADS, RWKV_HEAD))


def center_shift(h):
    prev = jnp.pad(h[:, :-1], ((0, 0), (1, 0), (0, 0)))
    nxt = jnp.pad(h[:, 1:], ((0, 0), (0, 1), (0, 0)))
    return 0.5 * (prev + nxt) - h


def rwkv7_features(h, mu, w_in, w_lora1, w_lora2, w0, a_lora1, a_lora2, a0, k_k, k_a):
    xx = center_shift(h)
    xs = h[:, :, None, :] + xx[:, :, None, :] * mu
    rkvz = jnp.einsum('blcd,cde->blce', xs[:, :, :4], w_in)
    r, k, v, z = rkvz[:, :, 0], rkvz[:, :, 1], rkvz[:, :, 2], rkvz[:, :, 3]
    w_lora = jnp.einsum('nblr,nre->nble', jnp.tanh(jnp.einsum('bld,ndr->nblr', xs[:, :, 4], w_lora1)), w_lora2)
    log_w = -jax.nn.softplus(-(w0[:, None, None, :] + w_lora)) - 0.5
    decay = jnp.exp(-jnp.exp(log_w.astype(jnp.float32)))
    a = jax.nn.sigmoid(a0[:, None, None, :] + jnp.einsum('nblr,nre->nble', jnp.einsum('bld,ndr->nblr', xs[:, :, 5], a_lora1), a_lora2))
    kk = split_heads(k * k_k).astype(jnp.float32)
    kk = (kk * lax.rsqrt(jnp.sum(kk * kk, axis=-1, keepdims=True) + 1e-12)).reshape(k.shape)
    k_dir = k * (1 + (a - 1) * k_a)
    return r, decay, k_dir, v, kk, a, z


def to_scan_order(t_dir):
    return jnp.stack([t_dir[0], jnp.flip(t_dir[1], axis=1)])


def rwkv7_scan(state0, r, decay, k_dir, v, kk, a, emit):
    bsz, length = v.shape[:2]
    both = lambda t: jnp.broadcast_to(t, (2,) + t.shape)
    inputs = (decay, k_dir, both(v), both(kk), a) + ((both(r),) if emit else ())
    seqs = tuple(jnp.moveaxis(split_heads(to_scan_order(t).astype(jnp.float32)), 2, 0) for t in inputs)

    def step(S, inp):
        w_t, k_t, v_t, kk_t, a_t = inp[:5]
        s_kk = jnp.einsum('nbhvk,nbhk->nbhv', S, kk_t)
        S = S * w_t[..., None, :] - s_kk[..., :, None] * (kk_t * a_t)[..., None, :] + v_t[..., :, None] * k_t[..., None, :]
        y_t = jnp.einsum('nbhvk,nbhk->nbhv', S, inp[5]) if emit else None
        return S, y_t

    s_final, ys = lax.scan(step, state0, seqs)
    if not emit:
        return s_final, None
    ys = jnp.moveaxis(ys, 0, 2)
    y = ys[0] + jnp.flip(ys[1], axis=1)
    return s_final, y.reshape(bsz, length, RWKV_WIDTH)


def rwkv7_output(y, r, k_dir, v, z, r_k, ln_gain, ln_bias, w_out):
    yh = split_heads(y)
    mean = jnp.mean(yh, axis=-1, keepdims=True)
    var = jnp.mean(jnp.square(yh - mean), axis=-1, keepdims=True)
    yn = ((yh - mean) * lax.rsqrt(var + RWKV_LN_EPS)).reshape(y.shape) * ln_gain + ln_bias
    bonus = jnp.sum(split_heads(r)[None] * split_heads(k_dir) * r_k, axis=-1, keepdims=True) * split_heads(v)[None]
    out = (yn + jnp.sum(bonus, axis=0).reshape(y.shape)).astype(z.dtype)
    return (out * jax.nn.silu(z)) @ w_out


def axial_rope_tables(length):
    rows = length // GRID_W
    row = jnp.repeat(jnp.arange(rows, dtype=jnp.float32), GRID_W)
    col = jnp.tile(jnp.arange(GRID_W, dtype=jnp.float32), rows)
    inv_freq = ROPE_BASE ** (-jnp.arange(ROPE_FREQS_PER_AXIS, dtype=jnp.float32) / ROPE_FREQS_PER_AXIS)
    ang = jnp.concatenate([row[:, None] * inv_freq, col[:, None] * inv_freq], axis=-1)
    return jnp.cos(ang), jnp.sin(ang)


def apply_rope(t, cos, sin):
    t_nope, t_rope = jnp.split(t, [MLA_NOPE], axis=-1)
    x1, x2 = jnp.split(t_rope, 2, axis=-1)
    cs, sn = cos[:, None, :], sin[:, None, :]
    out = jnp.concatenate([t_nope, x1 * cs - x2 * sn, x1 * sn + x2 * cs], axis=-1)
    return out.astype(t.dtype)


def mla_project(h, w_in, q_norm, kv_norm, w_uq, w_ukv, qk_gain_q, qk_gain_k, need_q):
    bsz, length, _ = h.shape
    if need_q:
        c_q, c_kv, k_rope, z = jnp.split(h @ w_in, [MLA_Q_RANK, MLA_Q_RANK + MLA_KV_RANK, MLA_Q_RANK + MLA_KV_RANK + MLA_ROPE], axis=-1)
        q = (rms_norm(c_q, q_norm) @ w_uq).reshape(bsz, length, MLA_HEADS, MLA_QK_DIM)
        q = rms_norm(q, qk_gain_q)
    else:
        c_kv, k_rope = jnp.split(h @ w_in[:, MLA_Q_RANK:MLA_Q_RANK + MLA_KV_RANK + MLA_ROPE], [MLA_KV_RANK], axis=-1)
        q, z = None, None
    kv = (rms_norm(c_kv, kv_norm) @ w_ukv).reshape(bsz, length, MLA_HEADS, MLA_NOPE + MLA_VDIM)
    k_nope, v = jnp.split(kv, [MLA_NOPE], axis=-1)
    k = jnp.concatenate([k_nope, jnp.broadcast_to(k_rope[:, :, None, :], (bsz, length, MLA_HEADS, MLA_ROPE))], axis=-1)
    k = rms_norm(k, qk_gain_k)
    return q, k, v, z


def mla_latent_attention(q, k, v, k_ctx, v_ctx, cos, sin):
    bsz, length = q.shape[:2]
    n_ctx = k_ctx.shape[1]
    q_rot, k_rot = apply_rope(q, cos, sin), apply_rope(k, cos, sin)
    nblk = length // MLA_QBLOCK
    blocks = lambda t: jnp.moveaxis(t.reshape(bsz, nblk, MLA_QBLOCK, MLA_HEADS, MLA_QK_DIM), 1, 0)

    def one_block(qs):
        qr, qp = qs
        s = jnp.concatenate([jnp.einsum('bqhd,bkhd->bhqk', qp, k_ctx), jnp.einsum('bqhd,bkhd->bhqk', qr, k_rot)], axis=-1)
        p = jax.nn.softmax(s.astype(jnp.float32) * MLA_SCALE, axis=-1).astype(v.dtype)
        return jnp.einsum('bhqk,bkhd->bqhd', p[..., :n_ctx], v_ctx) + jnp.einsum('bhqk,bkhd->bqhd', p[..., n_ctx:], v)

    o = lax.map(one_block, (blocks(q_rot), blocks(q)))
    return jnp.moveaxis(o, 0, 1).reshape(bsz, length, MLA_WIDTH)


def mla_context_attention(q, k, v):
    bsz, n_ctx = q.shape[:2]
    p = jax.nn.softmax(jnp.einsum('bqhd,bkhd->bhqk', q, k).astype(jnp.float32) * MLA_SCALE, axis=-1).astype(v.dtype)
    return jnp.einsum('bhqk,bkhd->bqhd', p, v).reshape(bsz, n_ctx, MLA_WIDTH)


def setup_inputs(seed: int = 0) -> dict:
    key = jax.random.key(seed)
    it = iter(jax.random.split(key, 48))
    nrm = lambda shape, scale: scale * jax.random.normal(next(it), shape, jnp.float32)
    D = D_MODEL
    nA, nB, nC = N_SGU_LAYERS, N_RWKV_LAYERS, N_MLA_LAYERS
    return {
        'x': nrm((BATCH, SEQ, D), 1.0),
        'c': nrm((BATCH, D), 1.0),
        'ctx': nrm((BATCH, CTX_LEN, D), 1.0),
        'c_ctx': nrm((D,), 1.0),
        'ada_w': nrm((DEPTH, D, 3 * D), 0.5 * D ** -0.5),
        'ada_b': nrm((DEPTH, 3 * D), 0.02),
        'sgu_w_in': nrm((nA, D, 3 * SGU_WIDTH), D ** -0.5),
        'sgu_gain': 1.0 + nrm((nA, SGU_WIDTH), 0.02),
        'sgu_w_s': nrm((nA, SGU_GROUPS, SGU_CHUNK, SGU_CHUNK), SGU_CHUNK ** -0.5),
        'sgu_b_s': 1.0 + nrm((nA, SGU_GROUPS, SGU_CHUNK), 0.02),
        'sgu_w_out': nrm((nA, SGU_WIDTH, D), SGU_WIDTH ** -0.5),
        'rwkv_mu': jax.random.uniform(next(it), (nB, RWKV_N_LERP, D), jnp.float32),
        'rwkv_w_in': nrm((nB, 4, D, RWKV_WIDTH), D ** -0.5),
        'rwkv_w_lora1': nrm((nB, 2, D, RWKV_DECAY_LORA), D ** -0.5),
        'rwkv_w_lora2': nrm((nB, 2, RWKV_DECAY_LORA, RWKV_WIDTH), 0.5 * RWKV_DECAY_LORA ** -0.5),
        'rwkv_w0': -1.0 + nrm((nB, 2, RWKV_WIDTH), 0.5),
        'rwkv_a_lora1': nrm((nB, 2, D, RWKV_ICLR_LORA), D ** -0.5),
        'rwkv_a_lora2': nrm((nB, 2, RWKV_ICLR_LORA, RWKV_WIDTH), 0.5 * RWKV_ICLR_LORA ** -0.5),
        'rwkv_a0': nrm((nB, 2, RWKV_WIDTH), 0.1),
        'rwkv_k_k': 0.85 + nrm((nB, RWKV_WIDTH), 0.02),
        'rwkv_k_a': 1.0 + nrm((nB, RWKV_WIDTH), 0.02),
        'rwkv_r_k': nrm((nB, RWKV_HEADS, RWKV_HEAD), 0.1),
        'rwkv_ln_gain': 1.0 + nrm((nB, RWKV_WIDTH), 0.02),
        'rwkv_ln_bias': nrm((nB, RWKV_WIDTH), 0.02),
        'rwkv_w_out': nrm((nB, RWKV_WIDTH, D), RWKV_WIDTH ** -0.5),
        'mla_w_in': nrm((nC, D, MLA_Q_RANK + MLA_KV_RANK + MLA_ROPE + MLA_WIDTH), D ** -0.5),
        'mla_q_norm': 1.0 + nrm((nC, MLA_Q_RANK), 0.02),
        'mla_kv_norm': 1.0 + nrm((nC, MLA_KV_RANK), 0.02),
        'mla_w_uq': nrm((nC, MLA_Q_RANK, MLA_HEADS * MLA_QK_DIM), MLA_Q_RANK ** -0.5),
        'mla_w_ukv': nrm((nC, MLA_KV_RANK, MLA_HEADS * (MLA_NOPE + MLA_VDIM)), MLA_KV_RANK ** -0.5),
        'mla_qk_gain_q': 1.0 + nrm((nC, MLA_QK_DIM), 0.02),
        'mla_qk_gain_k': 1.0 + nrm((nC, MLA_QK_DIM), 0.02),
        'mla_w_out': nrm((nC, MLA_WIDTH, D), MLA_WIDTH ** -0.5),
    }


def reference(x, c, ctx, c_ctx, ada_w, ada_b, sgu_w_in, sgu_gain, sgu_w_s, sgu_b_s, sgu_w_out,
              rwkv_mu, rwkv_w_in, rwkv_w_lora1, rwkv_w_lora2, rwkv_w0, rwkv_a_lora1, rwkv_a_lora2, rwkv_a0,
              rwkv_k_k, rwkv_k_a, rwkv_r_k, rwkv_ln_gain, rwkv_ln_bias, rwkv_w_out,
              mla_w_in, mla_q_norm, mla_kv_norm, mla_w_uq, mla_w_ukv, mla_qk_gain_q, mla_qk_gain_k, mla_w_out):
    cos, sin = axial_rope_tables(x.shape[1])
    ctx_readers = [i for i in range(DEPTH) if i % N_MIXERS != 0]
    last_ctx_reader = ctx_readers[-1] if ctx_readers else -1
    for i in range(DEPTH):
        kind, j = i % N_MIXERS, i // N_MIXERS
        update_ctx = i < last_ctx_reader
        shift, scale, gate = ada_modulation(c, ada_w[i], ada_b[i])
        h = rms_norm(x) * (1 + scale) + shift
        if kind != 0 or update_ctx:
            c_shift, c_scale, c_gate = ada_modulation(c_ctx, ada_w[i], ada_b[i])
            hc = rms_norm(ctx) * (1 + c_scale) + c_shift
        if kind == 0:
            sgu_args = (sgu_w_in[j], sgu_gain[j], sgu_w_s[j], sgu_b_s[j], sgu_w_out[j])
            x = x + gate * sgu_mixer(h, *sgu_args)
            if update_ctx:
                ctx = ctx + c_gate * sgu_mixer(hc, *sgu_args)
        elif kind == 1:
            feat_args = (rwkv_mu[j], rwkv_w_in[j], rwkv_w_lora1[j], rwkv_w_lora2[j], rwkv_w0[j],
                         rwkv_a_lora1[j], rwkv_a_lora2[j], rwkv_a0[j], rwkv_k_k[j], rwkv_k_a[j])
            out_args = (rwkv_r_k[j], rwkv_ln_gain[j], rwkv_ln_bias[j], rwkv_w_out[j])
            r_c, w_c, kd_c, v_c, kk_c, a_c, z_c = rwkv7_features(hc, *feat_args)
            state0 = jnp.zeros((2, hc.shape[0], RWKV_HEADS, RWKV_HEAD, RWKV_HEAD), jnp.float32)
            s_ctx, y_c = rwkv7_scan(state0, r_c, w_c, kd_c, v_c, kk_c, a_c, emit=update_ctx)
            r_l, w_l, kd_l, v_l, kk_l, a_l, z_l = rwkv7_features(h, *feat_args)
            _, y_l = rwkv7_scan(s_ctx, r_l, w_l, kd_l, v_l, kk_l, a_l, emit=True)
            x = x + gate * rwkv7_output(y_l, r_l, kd_l, v_l, z_l, *out_args)
            if update_ctx:
                ctx = ctx + c_gate * rwkv7_output(y_c, r_c, kd_c, v_c, z_c, *out_args)
        else:
            mla_args = (mla_w_in[j], mla_q_norm[j], mla_kv_norm[j], mla_w_uq[j], mla_w_ukv[j],
                        mla_qk_gain_q[j], mla_qk_gain_k[j])
            q_c, k_c, v_c, z_c = mla_project(hc, *mla_args, need_q=update_ctx)
            q_l, k_l, v_l, z_l = mla_project(h, *mla_args, need_q=True)
            o_l = mla_latent_attention(q_l, k_l, v_l, k_c, v_c, cos, sin)
            x = x + gate * ((o_l * jax.nn.silu(z_l)) @ mla_w_out[j])
            if update_ctx:
                o_c = mla_context_attention(q_c, k_c, v_c)
                ctx = ctx + c_gate * ((o_c * jax.nn.silu(z_c)) @ mla_w_out[j])
    return x
```

```cpp
#include <hip/hip_runtime.h>
#include <hip/hip_cooperative_groups.h>
#include <cstdio>
#include <cstdint>
namespace cg = cooperative_groups;

#define DI __device__ __forceinline__
typedef unsigned short u16;
typedef short bf16x8 __attribute__((ext_vector_type(8)));
typedef float f32x16 __attribute__((ext_vector_type(16)));
typedef float f32x4 __attribute__((ext_vector_type(4)));
typedef float f32x2 __attribute__((ext_vector_type(2)));
typedef unsigned u32x4 __attribute__((ext_vector_type(4)));
typedef unsigned u32x2 __attribute__((ext_vector_type(2)));
typedef _Float16 h16;
typedef _Float16 h16x8 __attribute__((ext_vector_type(8)));
typedef _Float16 h16x4 __attribute__((ext_vector_type(4)));

constexpr int D = 1024, NB = 8, SEQ = 8192, CTXL = 256;
constexpr int T = NB * SEQ;
constexpr int TC = NB * CTXL;
constexpr int MALL = T + TC;
constexpr int SMEM_BYTES = 73728;
constexpr int NTHREADS = 256;
#ifndef LB2
#define LB2 2
#endif

constexpr size_t MB = 1ull << 20;
constexpr size_t OFF_W = 0;
constexpr size_t W_SGUIN = 0;
constexpr size_t W_SGUOUT = W_SGUIN + 2ull * 6144 * 1024;
constexpr size_t W_RIN = W_SGUOUT + 2ull * 1024 * 2048;
constexpr size_t W_L1W = W_RIN + 4ull * 1024 * 1024;
constexpr size_t W_L1A = W_L1W + 128ull * 1024;
constexpr size_t W_ROUT = W_L1A + 128ull * 1024;
constexpr size_t W_MIN = W_ROUT + 1024ull * 1024;
constexpr size_t W_UQ = W_MIN + 3200ull * 1024;
constexpr size_t W_UKV = W_UQ + 3072ull * 768;
constexpr size_t W_MOUT = W_UKV + 4096ull * 256;
constexpr size_t W_L2W = W_MOUT + 1024ull * 2048;
constexpr size_t W_L2A = W_L2W + 2ull * 1024 * 64;
constexpr size_t W_END = W_L2A + 2ull * 1024 * 64;
static_assert(W_END * 2 <= 64 * MB, "weights region");
constexpr size_t OFF_MOD = 64 * MB;
constexpr size_t OFF_CS = OFF_MOD + 512 * 1024;
constexpr size_t OFF_MU16 = OFF_CS + 32 * 1024;
constexpr size_t OFF_BAR = OFF_CS + 48 * 1024;
constexpr size_t OFF_SSQA = OFF_CS + 64 * 1024;
constexpr size_t OFF_SSQB = OFF_SSQA + 512 * 1024;
constexpr size_t OFF_SSQR = OFF_SSQB + 512 * 1024;
constexpr size_t OFF_CTX = 66 * MB;
constexpr size_t OFF_BIG = 76 * MB;
constexpr size_t SZ_ACT = (size_t)MALL * 1024 * 2;
constexpr size_t OFF_H = OFF_BIG;
constexpr size_t OFF_GUZ = OFF_H + SZ_ACT;
constexpr size_t OFF_GVT = OFF_GUZ + 2 * SZ_ACT;
constexpr size_t OFF_R = OFF_H + SZ_ACT;
constexpr size_t OFF_K = OFF_R + SZ_ACT;
constexpr size_t OFF_V = OFF_K + SZ_ACT;
constexpr size_t OFF_Z = OFF_V + SZ_ACT;
constexpr size_t OFF_TW = OFF_Z + SZ_ACT;
constexpr size_t OFF_TA = OFF_TW + (size_t)MALL * 128 * 2;
constexpr size_t OFF_BS = OFF_TA + (size_t)MALL * 128 * 2;
constexpr size_t OFF_SUMM = OFF_BS + (size_t)MALL * 32 * 4;
constexpr size_t OFF_Y1 = OFF_SUMM;
constexpr int NUNIT = NB * 16 * 33;
constexpr size_t RWKV_END = OFF_SUMM + (size_t)NUNIT * 4 * 4096 * 2;
constexpr size_t OFF_CQ = OFF_H + SZ_ACT;
constexpr size_t OFF_CKV = OFF_CQ + (size_t)T * 768 * 2;
constexpr size_t OFF_KR = OFF_CKV + (size_t)MALL * 256 * 2;
constexpr size_t OFF_SZ = OFF_KR + (size_t)MALL * 64 * 4;
constexpr size_t OFF_QX = OFF_SZ + (size_t)T * 2048 * 2;
constexpr size_t OFF_KX = OFF_QX + 16384ull * 16 * 256 * 2;
constexpr size_t OFF_VT = OFF_KX + 2ull * 8448 * 16 * 192 * 2;
constexpr size_t MLA_END = OFF_VT + 2ull * 16 * 128 * 8448 * 2;
constexpr size_t WS_NEED = (RWKV_END > MLA_END ? RWKV_END : MLA_END);
static_assert(WS_NEED <= 1024 * MB, "workspace");
static_assert(OFF_GVT + 2 * SZ_ACT <= 1024 * MB, "workspace sgu");

struct Params {
  const float *x, *c, *ctx, *c_ctx, *ada_w, *ada_b;
  const float *sgu_w_in, *sgu_gain, *sgu_w_s, *sgu_b_s, *sgu_w_out;
  const float *rwkv_mu, *rwkv_w_in, *rwkv_w_lora1, *rwkv_w_lora2, *rwkv_w0, *rwkv_a_lora1, *rwkv_a_lora2, *rwkv_a0;
  const float *rwkv_k_k, *rwkv_k_a, *rwkv_r_k, *rwkv_ln_gain, *rwkv_ln_bias, *rwkv_w_out;
  const float *mla_w_in, *mla_q_norm, *mla_kv_norm, *mla_w_uq, *mla_w_ukv, *mla_qk_gain_q, *mla_qk_gain_k, *mla_w_out;
  float* out;
  char* ws;
};

DI u16 f2bf(float x) { unsigned u = __float_as_uint(x); u += 0x7fffu + ((u >> 16) & 1u); return (u16)(u >> 16); }
typedef __bf16 bf16x2_t __attribute__((ext_vector_type(2)));
DI unsigned pack2bf(float a, float b) { const f32x2 v = (f32x2){a, b}; return __builtin_bit_cast(unsigned, __builtin_convertvector(v, bf16x2_t)); }
DI float bflo(unsigned v) { return __uint_as_float(v << 16); }
DI float bfhi(unsigned v) { return __uint_as_float(v & 0xffff0000u); }
DI float sigmoidf_(float x) { return __builtin_amdgcn_rcpf(1.0f + __builtin_amdgcn_exp2f(-1.4426950408889634f * x)); }
DI float siluf_(float x) { return x * sigmoidf_(x); }
DI float geluf_(float x) { const float u = 0.7978845608028654f * (x + 0.044715f * x * x * x); return x * sigmoidf_(2.0f * u); }
DI int crow(int i, int h) { return (i & 3) + 8 * (i >> 2) + 4 * h; }
DI float wave_sum(float v) {
#pragma unroll
  for (int o = 32; o >= 1; o >>= 1) v += __shfl_xor(v, o);
  return v;
}
#define MFMA(a, b, c) __builtin_amdgcn_mfma_f32_32x32x16_bf16((a), (b), (c), 0, 0, 0)

DI int mod_row(int row) { return row < T ? (row >> 13) : 8; }

constexpr int LROW = 144;
template <int MI, int NI, bool F16 = false, class XL, class EPI>
DI void gemm_tile(const XL& xl, const u16* __restrict__ Wt, int ldw, int K, const EPI& epi, char* smem) {
  constexpr int BN = NI * 32, BM = MI * 128;
  constexpr int WCH = BN * 8 / NTHREADS, XCH = BM * 8 / NTHREADS;
  int tid_ = threadIdx.x; asm volatile("" : "+v"(tid_));
  const int tid = tid_, lane = tid & 63, w = tid >> 6, r = lane & 31, h = lane >> 5;
  char* Xs = smem;
  char* Ws = smem + BM * LROW;
  u32x4 xr[XCH], wr[WCH];
  f32x16 acc[MI][NI];
#pragma unroll
  for (int mi = 0; mi < MI; ++mi)
#pragma unroll
    for (int ni = 0; ni < NI; ++ni)
#pragma unroll
      for (int i = 0; i < 16; ++i) acc[mi][ni][i] = 0.f;
#pragma unroll
  for (int j = 0; j < XCH; ++j) { const int c = tid + NTHREADS * j; xr[j] = xl(c >> 3, (c & 7) * 8); }
#pragma unroll
  for (int j = 0; j < WCH; ++j) { const int c = tid + NTHREADS * j; wr[j] = *(const u32x4*)(Wt + (unsigned)((c >> 3) * ldw + (c & 7) * 8)); }
  for (int k0 = 0; k0 < K; k0 += 64) {
    __syncthreads();
#pragma unroll
    for (int j = 0; j < XCH; ++j) { const int c = tid + NTHREADS * j; *(u32x4*)(Xs + (c >> 3) * LROW + (c & 7) * 16) = xr[j]; }
#pragma unroll
    for (int j = 0; j < WCH; ++j) { const int c = tid + NTHREADS * j; *(u32x4*)(Ws + (c >> 3) * LROW + (c & 7) * 16) = wr[j]; }
    if (k0 + 64 < K) {
#pragma unroll
      for (int j = 0; j < XCH; ++j) { const int c = tid + NTHREADS * j; xr[j] = xl(c >> 3, k0 + 64 + (c & 7) * 8); }
#pragma unroll
      for (int j = 0; j < WCH; ++j) { const int c = tid + NTHREADS * j; wr[j] = *(const u32x4*)(Wt + (unsigned)((c >> 3) * ldw + k0 + 64 + (c & 7) * 8)); }
    }
    __syncthreads();
#pragma unroll
    for (int s = 0; s < 4; ++s) {
      bf16x8 xf[MI];
#pragma unroll
      for (int mi = 0; mi < MI; ++mi) xf[mi] = *(const bf16x8*)(Xs + (32 * (MI * w + mi) + r) * LROW + (16 * s + 8 * h) * 2);
#pragma unroll
      for (int ni = 0; ni < NI; ++ni) {
        const bf16x8 wf = *(const bf16x8*)(Ws + (32 * ni + r) * LROW + (16 * s + 8 * h) * 2);
#pragma unroll
        for (int mi = 0; mi < MI; ++mi) {
          if (F16) acc[mi][ni] = __builtin_amdgcn_mfma_f32_32x32x16_f16(__builtin_bit_cast(h16x8, wf), __builtin_bit_cast(h16x8, xf[mi]), acc[mi][ni], 0, 0, 0);
          else acc[mi][ni] = MFMA(wf, xf[mi], acc[mi][ni]);
        }
      }
    }
  }
#pragma unroll
  for (int mi = 0; mi < MI; ++mi) epi(acc[mi], MI * w + mi, r, h);
}


typedef __attribute__((address_space(3))) void* lds_ptr_t;
typedef const __attribute__((address_space(1))) void* glb_ptr_t;
constexpr int GL_STAGE = 24576;
template <class EPI>
DI void gemm_tile_glds(const u16* __restrict__ X, int ldx, const u16* __restrict__ Wt, int ldw, int K, const EPI& epi, char* smem) {
  int tid_ = threadIdx.x; asm volatile("" : "+v"(tid_));
  const int tid = tid_, lane = tid & 63, w = tid >> 6, r = lane & 31, h = lane >> 5;
  const int cs = (tid & 3) ^ ((tid >> 4) & 3);
  const u16* gx = X + (unsigned)((tid >> 2) * ldx + cs * 8);
  const u16* gw = Wt + (unsigned)((tid >> 2) * ldw + cs * 8);
  char* ldst = smem + tid * 16;
  f32x16 acc[2][4];
#pragma unroll
  for (int mi = 0; mi < 2; ++mi)
#pragma unroll
    for (int ni = 0; ni < 4; ++ni)
#pragma unroll
      for (int i = 0; i < 16; ++i) acc[mi][ni][i] = 0.f;
  const int NK = K >> 5;
  auto issue = [&](int kt) {
    char* d = ldst + (kt % 3) * GL_STAGE;
    const u16* sx = gx + kt * 32; const u16* sw = gw + kt * 32;
#pragma unroll
    for (int i = 0; i < 4; ++i) __builtin_amdgcn_global_load_lds((glb_ptr_t)(sx + (unsigned)(i * 64 * ldx)), (lds_ptr_t)(d + i * 4096), 16, 0, 0);
#pragma unroll
    for (int i = 0; i < 2; ++i) __builtin_amdgcn_global_load_lds((glb_ptr_t)(sw + (unsigned)(i * 64 * ldw)), (lds_ptr_t)(d + 16384 + i * 4096), 16, 0, 0);
  };
  asm volatile("s_waitcnt vmcnt(0)" ::: "memory");
  __builtin_amdgcn_s_barrier();
  asm volatile("" ::: "memory");
  issue(0); issue(1);
  const int swz = (r >> 2) & 3;
  int xo2[2], wo2[2];
#pragma unroll
  for (int s2 = 0; s2 < 2; ++s2) { const int cofs = ((2 * s2 + h) ^ swz) << 4; xo2[s2] = (64 * w + r) * 64 + cofs; wo2[s2] = 16384 + r * 64 + cofs; }
#pragma unroll 1
  for (int kt = 0; kt < NK; ++kt) {
    if (kt + 1 < NK) asm volatile("s_waitcnt vmcnt(6)" ::: "memory"); else asm volatile("s_waitcnt vmcnt(0)" ::: "memory");
    __builtin_amdgcn_s_barrier();
    asm volatile("" ::: "memory");
    if (kt + 2 < NK) issue(kt + 2);
    const char* sb = smem + (kt % 3) * GL_STAGE;
#pragma unroll
    for (int s2 = 0; s2 < 2; ++s2) {
      bf16x8 xf[2];
#pragma unroll
      for (int mi = 0; mi < 2; ++mi) xf[mi] = *(const bf16x8*)(sb + xo2[s2] + mi * 2048);
#pragma unroll
      for (int ni = 0; ni < 4; ++ni) {
        const bf16x8 wf = *(const bf16x8*)(sb + wo2[s2] + ni * 2048);
#pragma unroll
        for (int mi = 0; mi < 2; ++mi) acc[mi][ni] = MFMA(wf, xf[mi], acc[mi][ni]);
      }
    }
    asm volatile("" ::: "memory");
  }
#pragma unroll
  for (int mi = 0; mi < 2; ++mi) epi(acc[mi], 2 * w + mi, r, h);
}

struct XPlain {
  const u16* base; int ld;
  DI u32x4 operator()(int row, int k) const { return *(const u32x4*)(base + (unsigned)(row * ld + k)); }
};

struct Job { const float* src; u16* dst; int K, Nsrc, Ndst, map; const float* scale; int f16; };
constexpr int NJOBS = 21;
DI Job get_job(const Params& p, int j) {
  u16* W = (u16*)(p.ws + OFF_W);
  Job jb; jb.scale = nullptr; jb.map = 0; jb.f16 = 0;
  if (j < 2) { jb.src = p.sgu_w_in + (size_t)j * 1024 * 6144; jb.dst = W + W_SGUIN + (size_t)j * 6144 * 1024; jb.K = 1024; jb.Nsrc = 6144; jb.Ndst = 6144; jb.map = 1; }
  else if (j < 4) { jb.src = p.sgu_w_out + (size_t)(j - 2) * 2048 * 1024; jb.dst = W + W_SGUOUT + (size_t)(j - 2) * 1024 * 2048; jb.K = 2048; jb.Nsrc = 1024; jb.Ndst = 1024; }
  else if (j < 8) { jb.src = p.rwkv_w_in + (size_t)(j - 4) * 1024 * 1024; jb.dst = W + W_RIN + (size_t)(j - 4) * 1024 * 1024; jb.K = 1024; jb.Nsrc = 1024; jb.Ndst = 1024; }
  else if (j < 10) { jb.src = p.rwkv_w_lora1 + (size_t)(j - 8) * 1024 * 64; jb.dst = W + W_L1W + (size_t)(j - 8) * 64 * 1024; jb.K = 1024; jb.Nsrc = 64; jb.Ndst = 64; }
  else if (j < 12) { jb.src = p.rwkv_a_lora1 + (size_t)(j - 10) * 1024 * 64; jb.dst = W + W_L1A + (size_t)(j - 10) * 64 * 1024; jb.K = 1024; jb.Nsrc = 64; jb.Ndst = 64; }
  else if (j == 12) { jb.src = p.rwkv_w_out; jb.dst = W + W_ROUT; jb.K = 1024; jb.Nsrc = 1024; jb.Ndst = 1024; }
  else if (j == 13) { jb.src = p.mla_w_in; jb.dst = W + W_MIN; jb.K = 1024; jb.Nsrc = 3136; jb.Ndst = 3200; jb.map = 2; }
  else if (j == 14) { jb.src = p.mla_w_uq; jb.dst = W + W_UQ; jb.K = 768; jb.Nsrc = 3072; jb.Ndst = 3072; jb.scale = p.mla_q_norm; }
  else if (j == 15) { jb.src = p.mla_w_ukv; jb.dst = W + W_UKV; jb.K = 256; jb.Nsrc = 4096; jb.Ndst = 4096; jb.scale = p.mla_kv_norm; }
  else if (j == 16) { jb.src = p.mla_w_out; jb.dst = W + W_MOUT; jb.K = 2048; jb.Nsrc = 1024; jb.Ndst = 1024; }
  else if (j < 19) { jb.src = p.rwkv_w_lora2 + (size_t)(j - 17) * 64 * 1024; jb.dst = W + W_L2W + (size_t)(j - 17) * 1024 * 64; jb.K = 64; jb.Nsrc = 1024; jb.Ndst = 1024; jb.f16 = 1; }
  else { jb.src = p.rwkv_a_lora2 + (size_t)(j - 19) * 64 * 1024; jb.dst = W + W_L2A + (size_t)(j - 19) * 1024 * 64; jb.K = 64; jb.Nsrc = 1024; jb.Ndst = 1024; jb.f16 = 1; }
  return jb;
}
DI int map_col(int map, int n) {
  if (map == 0) return n;
  if (map == 1) {
    if (n >= 4096) return 2048 + (n - 4096);
    const int nt = n >> 7, j = n & 127, pp = j >> 6, ns = (j >> 5) & 1, cc = j & 31;
    const int ch = nt * 64 + pp * 32 + cc;
    return ns ? 4096 + ch : ch;
  }
  if (n < 1024) return n;
  if (n < 3072) return n + 64;
  if (n < 3136) return n - 2048;
  return -1;
}

DI void phase_prologue(const Params& p, char* smem) {
  const int tid = threadIdx.x;
  for (int item = blockIdx.x; ; item += gridDim.x) {
    if (item < 48) {
      float* cs = (float*)smem;
      for (int i = tid; i < 9 * 1024; i += NTHREADS) { const float v = i < 8192 ? p.c[i] : p.c_ctx[i - 8192]; cs[i] = siluf_(v); }
      __syncthreads();
      const int gi = item * 256 + tid; const int l = gi / 3072, n = gi % 3072;
      const float* wp = p.ada_w + (size_t)l * 1024 * 3072 + n;
      float a[9];
#pragma unroll
      for (int m = 0; m < 9; ++m) a[m] = p.ada_b[l * 3072 + n];
#pragma unroll 32
      for (int k = 0; k < 1024; ++k) { const float wv = wp[(size_t)k * 3072];
#pragma unroll
        for (int m = 0; m < 9; ++m) a[m] += cs[m * 1024 + k] * wv; }
      float* mo = (float*)(p.ws + OFF_MOD);
#pragma unroll
      for (int m = 0; m < 9; ++m) mo[((size_t)l * 9 + m) * 3072 + n] = a[m];
      __syncthreads();
      continue;
    }
    if (item == 48) {
      f32x2* cs = (f32x2*)(p.ws + OFF_CS);
      for (int i = tid; i < 3072; i += NTHREADS) {
        const int pos = i < 2048 ? (i >> 4) : ((i - 2048) >> 4); const int f = i & 15;
        const float invf = exp2f(-(float)f * (13.287712379549449f / 16.0f));
        const float ang = (float)pos * invf; float s, c; sincosf(ang, &s, &c);
        cs[i] = (f32x2){c, s};
      }
      h16* mu16 = (h16*)(p.ws + OFF_MU16);
      for (int i = tid; i < 6 * 1024; i += NTHREADS) mu16[i] = (h16)p.rwkv_mu[i];
      continue;
    }
    int ti = item - 49; int j = 0; Job jb;
    for (; j < NJOBS; ++j) { jb = get_job(p, j); const int nt = (jb.Ndst / 64) * (jb.K / 64); if (ti < nt) break; ti -= nt; }
    if (j >= NJOBS) break;
    const int nkt = jb.K / 64; const int nt = ti / nkt, kt = ti % nkt;
    float* tile = (float*)smem;
#pragma unroll 4
    for (int q = 0; q < 16; ++q) {
      const int kk = (tid >> 6) + 4 * q, nn = tid & 63; const int sc = map_col(jb.map, nt * 64 + nn); const int k = kt * 64 + kk;
      float v = 0.f; if (sc >= 0) { v = jb.src[(size_t)k * jb.Nsrc + sc]; if (jb.scale) v *= jb.scale[k]; }
      tile[nn * 65 + kk] = v;
    }
    __syncthreads();
    { const int nn = tid >> 2, kq = tid & 3; unsigned o[8];
#pragma unroll
      for (int q = 0; q < 8; ++q) { const float a = tile[nn * 65 + kq * 16 + 2 * q], b = tile[nn * 65 + kq * 16 + 2 * q + 1];
        if (jb.f16) { const h16 ha = (h16)a, hb = (h16)b; o[q] = (unsigned)__builtin_bit_cast(u16, ha) | ((unsigned)__builtin_bit_cast(u16, hb) << 16); } else o[q] = pack2bf(a, b); }
      u32x4* dp = (u32x4*)(jb.dst + (size_t)(nt * 64 + nn) * jb.K + kt * 64 + kq * 16);
      dp[0] = (u32x4){o[0], o[1], o[2], o[3]}; dp[1] = (u32x4){o[4], o[5], o[6], o[7]}; }
    __syncthreads();
  }
}

DI void phase_norm(const Params& p, int l, int nrows) {
  const int lane = threadIdx.x & 63, w = threadIdx.x >> 6;
  const float* mo = (const float*)(p.ws + OFF_MOD) + (size_t)l * 9 * 3072;
  u16* H = (u16*)(p.ws + OFF_H);
  float* sa = (float*)(p.ws + OFF_SSQA); float* sb = (float*)(p.ws + OFF_SSQB);
  for (int row = blockIdx.x * 4 + w; row < nrows; row += gridDim.x * 4) {
    const float* xs = row < T ? ((l == 0 ? p.x : p.out) + (size_t)row * D) : ((l == 0 ? p.ctx : (const float*)(p.ws + OFF_CTX)) + (size_t)(row - T) * D);
    f32x4 v[4]; float ss = 0.f;
#pragma unroll
    for (int j = 0; j < 4; ++j) { v[j] = *(const f32x4*)(xs + lane * 4 + 256 * j); ss += v[j][0] * v[j][0] + v[j][1] * v[j][1] + v[j][2] * v[j][2] + v[j][3] * v[j][3]; }
    ss = wave_sum(ss);
    const float rinv = rsqrtf(ss * (1.0f / 1024.0f) + 1e-6f);
    const float* m = mo + (size_t)mod_row(row) * 3072;
#pragma unroll
    for (int j = 0; j < 4; ++j) {
      const int cidx = lane * 4 + 256 * j;
      const f32x4 sh = *(const f32x4*)(m + cidx), sc = *(const f32x4*)(m + 1024 + cidx);
      float o[4];
#pragma unroll
      for (int e = 0; e < 4; ++e) o[e] = v[j][e] * rinv * (1.0f + sc[e]) + sh[e];
      *(u32x2*)(H + (size_t)row * D + cidx) = (u32x2){pack2bf(o[0], o[1]), pack2bf(o[2], o[3])};
    }
    if (lane == 0) { sa[row] = 0.f; sb[row] = 0.f; }
  }
}

DI void stagger(int nsleep) { if (blockIdx.x >= 256) for (int i = 0; i < nsleep; ++i) __builtin_amdgcn_s_sleep(127); }
struct EpiResidual {
  const Params* p; int l, m0, n0;
  DI void operator()(const f32x16 (&acc)[4], int w, int r, int h) const {
    const int row = m0 + 32 * w + r;
    const float* xin; float* xo;
    if (row < T) { xin = (l == 0 ? p->x : p->out) + (size_t)row * D; xo = p->out + (size_t)row * D; }
    else { xin = (l == 0 ? p->ctx : (const float*)(p->ws + OFF_CTX)) + (size_t)(row - T) * D; xo = (float*)(p->ws + OFF_CTX) + (size_t)(row - T) * D; }
    const float* g = (const float*)(p->ws + OFF_MOD) + ((size_t)l * 9 + mod_row(row)) * 3072 + 2048;
#pragma unroll
    for (int hf = 0; hf < 2; ++hf) {
      f32x4 xv[8], gv[8];
#pragma unroll
      for (int j = 0; j < 8; ++j) { const int ni = 2 * hf + (j >> 2), q = j & 3; const int n = n0 + 32 * ni + 8 * q + 4 * h; xv[j] = *(const f32x4*)(xin + n); gv[j] = *(const f32x4*)(g + n); }
#pragma unroll
      for (int j = 0; j < 8; ++j) { const int ni = 2 * hf + (j >> 2), q = j & 3; const int n = n0 + 32 * ni + 8 * q + 4 * h;
        f32x4 o;
#pragma unroll
        for (int e = 0; e < 4; ++e) o[e] = xv[j][e] + gv[j][e] * acc[ni][4 * q + e];
        *(f32x4*)(xo + n) = o; }
    }
  }
};
DI void phase_outproj(const Params& p, int l, const u16* X, int K, const u16* Wt, int nrows, char* smem) {
  const int ntile = (nrows / 256) * 8;
  for (int t = blockIdx.x; t < ntile; t += gridDim.x) {
    const int xcd = t & 7, lg = t >> 3; const int mt = (lg >> 3) * 8 + xcd, nt = lg & 7;
    EpiResidual ep{&p, l, mt * 256, nt * 128};
    gemm_tile_glds(X + (size_t)mt * 256 * K, K, Wt + (size_t)nt * 128 * K, K, K, ep, smem);
  }
}

struct EpiSguUZ {
  u16* guz; int m0, nt;
  DI void operator()(const f32x16 (&acc)[4], int w, int r, int h) const {
    const int row = m0 + 32 * w + r;
#pragma unroll
    for (int pp = 0; pp < 2; ++pp)
#pragma unroll
      for (int q = 0; q < 4; ++q) {
        float o[4];
#pragma unroll
        for (int e = 0; e < 4; ++e) {
          const float u = acc[2 * pp][4 * q + e], z = acc[2 * pp + 1][4 * q + e];
          const float a2 = 1.5957691216057308f * (u + 0.044715f * u * u * u);
          const float e1 = __builtin_amdgcn_exp2f(-1.4426950408889634f * a2), e2 = __builtin_amdgcn_exp2f(-1.4426950408889634f * z);
          const float den = fminf((1.0f + e1) * (1.0f + e2), 3.0e38f);
          o[e] = u * z * __builtin_amdgcn_rcpf(den);
        }
        *(u32x2*)(guz + (size_t)row * 2048 + nt * 64 + 32 * pp + 8 * q + 4 * h) = (u32x2){pack2bf(o[0], o[1]), pack2bf(o[2], o[3])};
      }
  }
};
struct EpiSguV {
  u16* gvt; float* ssq; int m0, c0;
  DI void operator()(const f32x16 (&acc)[4], int w, int r, int h) const {
    const int qrow = 32 * w + r; const int chunk = (m0 + qrow) >> 7; const int qpos = qrow & 127;
    float ss = 0.f;
#pragma unroll
    for (int ni = 0; ni < 4; ++ni)
#pragma unroll
      for (int i = 0; i < 16; ++i) {
        const float g = geluf_(acc[ni][i]); ss += g * g;
        gvt[((size_t)chunk * 2048 + c0 + 32 * ni + crow(i, h)) * 128 + qpos] = f2bf(g);
      }
    ss += __shfl_xor(ss, 32);
    if (h == 0) atomicAdd(ssq + m0 + qrow, ss);
  }
};
DI void phase_sgu_g1(const Params& p, int l, int nrows, char* smem) {
  const u16* H = (const u16*)(p.ws + OFF_H);
  const u16* Wt = (const u16*)(p.ws + OFF_W) + W_SGUIN + (size_t)(l ? 1 : 0) * 6144 * 1024;
  const int ntile = (nrows / 256) * 48;
  for (int t = blockIdx.x; t < ntile; t += gridDim.x) {
    const int mt = t / 48, nt = t % 48;
    const u16* xp = H + (size_t)mt * 256 * D;
    if (nt < 32) { EpiSguUZ ep{(u16*)(p.ws + OFF_GUZ), mt * 256, nt}; gemm_tile_glds(xp, D, Wt + (size_t)nt * 128 * D, D, D, ep, smem); }
    else { EpiSguV ep{(u16*)(p.ws + OFF_GVT), (float*)(p.ws + OFF_SSQA), mt * 256, (nt - 32) * 128}; gemm_tile_glds(xp, D, Wt + (size_t)nt * 128 * D, D, D, ep, smem); }
  }
}
struct EpiNull {
  float* sink;
  DI void operator()(const f32x16 (&acc)[4], int w, int r, int h) const {
    float t = 0.f;
#pragma unroll
    for (int ni = 0; ni < 4; ++ni)
#pragma unroll
      for (int i = 0; i < 16; ++i) t += acc[ni][i];
    if (t == 1.2345e38f) sink[threadIdx.x] = t;
  }
};
DI void phase_sgu_g1_dry(const Params& p, int nrows, char* smem) {
  const u16* H = (const u16*)(p.ws + OFF_H);
  const u16* Wt = (const u16*)(p.ws + OFF_W) + W_SGUIN;
  const int ntile = (nrows / 256) * 48;
  for (int t = blockIdx.x; t < ntile; t += gridDim.x) {
    const int mt = t / 48, nt = t % 48;
    EpiNull ep{(float*)(p.ws + OFF_SSQR)};
    gemm_tile_glds(H + (size_t)mt * 256 * D, D, Wt + (size_t)nt * 128 * D, D, D, ep, smem);
  }
}
struct XSguMix {
  const float* ws_g; const float* rinv;
  DI u32x4 operator()(int row, int k) const {
    const f32x4 a = *(const f32x4*)(ws_g + row * 128 + k), b = *(const f32x4*)(ws_g + row * 128 + k + 4);
    const f32x4 ra = *(const f32x4*)(rinv + k), rb = *(const f32x4*)(rinv + k + 4);
    return (u32x4){pack2bf(a[0] * ra[0], a[1] * ra[1]), pack2bf(a[2] * ra[2], a[3] * ra[3]), pack2bf(b[0] * rb[0], b[1] * rb[1]), pack2bf(b[2] * rb[2], b[3] * rb[3])};
  }
};
struct EpiSguMix {
  u16* guz; const float* gain; const float* bs_g; int m0, c0;
  DI void operator()(const f32x16 (&acc)[4], int w, int r, int h) const {
    const int pp = 32 * w + r; const float bias = bs_g[pp];
    u16* rowp = guz + (size_t)(m0 + pp) * 2048 + c0;
    u32x2 gz[16];
#pragma unroll
    for (int j = 0; j < 16; ++j) gz[j] = *(const u32x2*)(rowp + 32 * (j >> 2) + 8 * (j & 3) + 4 * h);
#pragma unroll
    for (int j = 0; j < 16; ++j) {
      const int ni = j >> 2, q = j & 3; const int n = 32 * ni + 8 * q + 4 * h;
      const f32x4 gn = *(const f32x4*)(gain + c0 + n);
      const float o0 = (acc[ni][4 * q] * gn[0] + bias) * bflo(gz[j][0]), o1 = (acc[ni][4 * q + 1] * gn[1] + bias) * bfhi(gz[j][0]);
      const float o2 = (acc[ni][4 * q + 2] * gn[2] + bias) * bflo(gz[j][1]), o3 = (acc[ni][4 * q + 3] * gn[3] + bias) * bfhi(gz[j][1]);
      *(u32x2*)(rowp + n) = (u32x2){pack2bf(o0, o1), pack2bf(o2, o3)};
    }
  }
};
struct EpiSguMix8 {
  u16* guz; const float* gain; const float* bs_g; int m0, c0;
  DI void operator()(const f32x16 (&acc)[8], int w, int r, int h) const {
    const int pp = 32 * w + r; const float bias = bs_g[pp];
    u16* rowp = guz + (size_t)(m0 + pp) * 2048 + c0;
#pragma unroll
    for (int hf = 0; hf < 2; ++hf) {
      u32x2 gz[16];
#pragma unroll
      for (int j = 0; j < 16; ++j) gz[j] = *(const u32x2*)(rowp + 128 * hf + 32 * (j >> 2) + 8 * (j & 3) + 4 * h);
#pragma unroll
      for (int j = 0; j < 16; ++j) {
        const int ni = 4 * hf + (j >> 2), q = j & 3; const int n = 32 * ni + 8 * q + 4 * h;
        const f32x4 gn = *(const f32x4*)(gain + c0 + n);
        const float o0 = (acc[ni][4 * q] * gn[0] + bias) * bflo(gz[j][0]), o1 = (acc[ni][4 * q + 1] * gn[1] + bias) * bfhi(gz[j][0]);
        const float o2 = (acc[ni][4 * q + 2] * gn[2] + bias) * bflo(gz[j][1]), o3 = (acc[ni][4 * q + 3] * gn[3] + bias) * bfhi(gz[j][1]);
        *(u32x2*)(rowp + n) = (u32x2){pack2bf(o0, o1), pack2bf(o2, o3)};
      }
    }
  }
};
DI void phase_sgu_mix(const Params& p, int l, int nrows, char* smem) {
  const int lj = l ? 1 : 0;
  const float* ssq = (const float*)(p.ws + OFF_SSQA);
  float* rinv = (float*)(smem + 57344);
  const int ntile = (nrows / 128) * 8;
  for (int t = blockIdx.x; t < ntile; t += gridDim.x) {
    const int chunk = t >> 3, g = t & 7;
    __syncthreads();
    if (threadIdx.x < 128) rinv[threadIdx.x] = rsqrtf(ssq[chunk * 128 + threadIdx.x] * (1.0f / 2048.0f) + 1e-6f);
    __syncthreads();
    XSguMix xl{p.sgu_w_s + ((size_t)lj * 8 + g) * 128 * 128, rinv};
    const int c0 = g * 256;
    EpiSguMix8 ep{(u16*)(p.ws + OFF_GUZ), p.sgu_gain + (size_t)lj * 2048, p.sgu_b_s + ((size_t)lj * 8 + g) * 128, chunk * 128, c0};
    gemm_tile<1, 8>(xl, (const u16*)(p.ws + OFF_GVT) + ((size_t)chunk * 2048 + c0) * 128, 128, 128, ep, smem);
  }
}

struct XLerp {
  const u16* H; const float* mu; int m0;
  DI u32x4 operator()(int row, int k) const {
    const int grow = m0 + row;
    int pos, len; if (grow < T) { pos = grow & (SEQ - 1); len = SEQ; } else { pos = (grow - T) & (CTXL - 1); len = CTXL; }
    const u16* hp = H + (size_t)grow * D + k;
    const u32x4 c = *(const u32x4*)hp;
    u32x4 a = (u32x4){0u, 0u, 0u, 0u}, b = (u32x4){0u, 0u, 0u, 0u};
    if (pos > 0) a = *(const u32x4*)(hp - D);
    if (pos < len - 1) b = *(const u32x4*)(hp + D);
    const f32x4 m0v = *(const f32x4*)(mu + k), m1v = *(const f32x4*)(mu + k + 4);
    u32x4 o;
#pragma unroll
    for (int e = 0; e < 4; ++e) {
      const float c0 = bflo(c[e]), c1 = bfhi(c[e]);
      const float x0 = 0.5f * (bflo(a[e]) + bflo(b[e])) - c0, x1 = 0.5f * (bfhi(a[e]) + bfhi(b[e])) - c1;
      const float mu0 = e < 2 ? m0v[2 * e] : m1v[2 * e - 4], mu1 = e < 2 ? m0v[2 * e + 1] : m1v[2 * e - 3];
      o[e] = pack2bf(c0 + x0 * mu0, c1 + x1 * mu1);
    }
    return o;
  }
};
template <int NI>
struct EpiF16 {
  h16* O; int ld, m0, n0; bool tanh_;
  DI void operator()(const f32x16 (&acc)[NI], int w, int r, int h) const {
    h16* rowp = O + (size_t)(m0 + 32 * w + r) * ld + n0;
#pragma unroll
    for (int ni = 0; ni < NI; ++ni)
#pragma unroll
      for (int q = 0; q < 4; ++q) {
        h16x4 o;
#pragma unroll
        for (int e = 0; e < 4; ++e) { float v = acc[ni][4 * q + e]; if (tanh_) v = 2.0f * sigmoidf_(2.0f * v) - 1.0f; o[e] = (h16)v; }
        *(h16x4*)(rowp + 32 * ni + 8 * q + 4 * h) = o;
      }
  }
};
DI void phase_rwkv_g(const Params& p, char* smem) {
  const u16* H = (const u16*)(p.ws + OFF_H);
  const u16* W = (const u16*)(p.ws + OFF_W);
  for (int vb = blockIdx.x; (vb >> 3) < 1188; vb += gridDim.x) {
    const int xcd = vb & 7, lg = vb >> 3;
    if (lg < 1056) {
      const int mt = lg >> 1, jt = xcd + 8 * (lg & 1); const int c = jt >> 2, nt = jt & 3;
      XLerp xl{H, p.rwkv_mu + (size_t)c * 1024, mt * 128};
      EpiF16<8> ep{(h16*)(p.ws + OFF_R + (size_t)c * SZ_ACT), 1024, mt * 128, nt * 256, false};
      gemm_tile<1, 8>(xl, W + W_RIN + (size_t)c * 1024 * 1024 + (size_t)nt * 256 * 1024, 1024, 1024, ep, smem);
    } else {
      const int l2 = lg - 1056; const int mt = (l2 >> 1) * 8 + xcd, which = l2 & 1;
      XLerp xl{H, p.rwkv_mu + (size_t)(4 + which) * 1024, mt * 128};
      EpiF16<4> ep{(h16*)(p.ws + (which ? OFF_TA : OFF_TW)), 128, mt * 128, 0, which == 0};
      gemm_tile<1, 4>(xl, W + (which ? W_L1A : W_L1W), 1024, 1024, ep, smem);
    }
  }
}

DI int unit_row0(int u) { const int ch = u % 33, bh = u / 33, b = bh >> 4; return ch == 0 ? T + b * CTXL : b * SEQ + (ch - 1) * 256; }

template <bool PASS_C>
DI void phase_scan(const Params& p, char* smem) {
  const int tid = threadIdx.x, lane = tid & 63, w = tid >> 6, dir = w & 1;
  const bool isP = !PASS_C && (w >> 1);
  float* lb = (float*)(smem + w * 14336);
  float* kkb = lb, *rb = lb + 512, *wb = lb + 1024, *kab = lb + 1536, *kdb = lb + 2048, *vb = lb + 2560, *yob = lb + 3072;
  const h16* Rg = (const h16*)(p.ws + OFF_R); const h16* Kg = (const h16*)(p.ws + OFF_K); const h16* Vg = (const h16*)(p.ws + OFF_V);
  const h16* TWg = (const h16*)(p.ws + OFF_TW); const h16* TAg = (const h16*)(p.ws + OFF_TA);
  h16* Yg = (h16*)(p.ws + OFF_H);
  float* BSg = (float*)(p.ws + OFF_BS);
  h16* SUM = (h16*)(p.ws + OFF_SUMM);
  for (int up = blockIdx.x; up < (PASS_C ? NUNIT / 2 : NUNIT); up += gridDim.x) {
    const int u = PASS_C ? 2 * up + (w >> 1) : up;
    const int hd = (u / 33) & 15, ch = u % 33;
    const int row0 = unit_row0(u);
    const int col = hd * 64 + lane;
    const h16* W2Tw = (const h16*)((const u16*)(p.ws + OFF_W) + W_L2W) + (size_t)dir * 1024 * 64;
    const h16* W2Ta = (const h16*)((const u16*)(p.ws + OFF_W) + W_L2A) + (size_t)dir * 1024 * 64;
    f32x2 S[32];
#pragma unroll
    for (int q = 0; q < 32; ++q) S[q] = (f32x2){0.f, 0.f};
    if (PASS_C) {
      if (ch != 0) {
        const h16* sp = SUM + ((size_t)(u * 2 + dir) * 2 + 0) * 4096 + lane * 64;
#pragma unroll
        for (int q = 0; q < 8; ++q) { const h16x8 v = *(const h16x8*)(sp + 8 * q);
#pragma unroll
          for (int e = 0; e < 4; ++e) S[4 * q + e] = (f32x2){(float)v[2 * e], (float)v[2 * e + 1]}; }
      }
    } else {
#pragma unroll
      for (int q = 0; q < 32; ++q) { if (isP && lane == 2 * q) S[q][0] = 1.f; if (isP && lane == 2 * q + 1) S[q][1] = 1.f; }
    }
    for (int j = 0; j < 32; ++j) {
      const int sb = dir == 0 ? j : 31 - j;
      {
        const int col16 = lane & 15, quad = lane >> 4, ts = col16 & 7, eh = col16 >> 3;
        int w2off = (hd * 64 + col16) * 64 + 8 * quad; asm volatile("" : "+v"(w2off));
        const int tok = row0 + sb * 8 + (dir == 0 ? ts : 7 - ts);
        h16x8 bw[2], ba[2];
#pragma unroll
        for (int ks = 0; ks < 2; ++ks) { bw[ks] = *(const h16x8*)(TWg + (size_t)tok * 128 + dir * 64 + 32 * ks + 8 * quad); ba[ks] = *(const h16x8*)(TAg + (size_t)tok * 128 + dir * 64 + 32 * ks + 8 * quad); }
        f32x4 cw[4], ca[4];
#pragma unroll
        for (int et = 0; et < 4; ++et) {
          cw[et] = (f32x4){0.f, 0.f, 0.f, 0.f}; ca[et] = (f32x4){0.f, 0.f, 0.f, 0.f};
#pragma unroll
          for (int ks = 0; ks < 2; ++ks) {
            const h16x8 aw = *(const h16x8*)(W2Tw + w2off + et * 1024 + 32 * ks);
            const h16x8 aa = *(const h16x8*)(W2Ta + w2off + et * 1024 + 32 * ks);
            cw[et] = __builtin_amdgcn_mfma_f32_16x16x32_f16(aw, bw[ks], cw[et], 0, 0, 0);
            ca[et] = __builtin_amdgcn_mfma_f32_16x16x32_f16(aa, ba[ks], ca[et], 0, 0, 0);
          }
        }
        float ssq = 0.f, bsum = 0.f;
        f32x4 kkr[2], kdv[2], axv[2], decv[2], rxv[2], vxv[2], yov[2];
#pragma unroll
        for (int t = 0; t < 2; ++t) {
          const int e0 = (2 * eh + t) * 16 + 4 * quad; const int c0 = hd * 64 + e0;
          const f32x4 wl4 = eh ? cw[2 + t] : cw[t], al4 = eh ? ca[2 + t] : ca[t];
          const size_t gi = (size_t)tok * 1024 + c0;
          const h16x4 k4 = *(const h16x4*)(Kg + gi), r4 = *(const h16x4*)(Rg + gi), v4 = *(const h16x4*)(Vg + gi);
          h16x4 y4 = (h16x4){(h16)0.f, (h16)0.f, (h16)0.f, (h16)0.f};
          if (PASS_C) { if (j >= 16) y4 = *(const h16x4*)(Yg + gi); }
          const f32x4 w04 = *(const f32x4*)(p.rwkv_w0 + dir * 1024 + c0), a04 = *(const f32x4*)(p.rwkv_a0 + dir * 1024 + c0);
          const f32x4 kk4 = *(const f32x4*)(p.rwkv_k_k + c0), ka4 = *(const f32x4*)(p.rwkv_k_a + c0), rk4 = *(const f32x4*)(p.rwkv_r_k + c0);
#pragma unroll
          for (int e = 0; e < 4; ++e) {
            const float kx = (float)k4[e], rx = (float)r4[e];
            const float kr = kx * kk4[e]; ssq += kr * kr; kkr[t][e] = kr;
            const float nx = -(wl4[e] + w04[e]); const float sp = fmaxf(nx, 0.f) + __logf(1.0f + __expf(-fabsf(nx)));
            decv[t][e] = __expf(-__expf(-sp - 0.5f));
            const float ax = sigmoidf_(al4[e] + a04[e]); axv[t][e] = ax;
            const float kd = kx * (1.0f + (ax - 1.0f) * ka4[e]); kdv[t][e] = kd;
            bsum += rx * kd * rk4[e]; rxv[t][e] = rx; vxv[t][e] = (float)v4[e]; yov[t][e] = (float)y4[e];
          }
        }
        ssq += __shfl_xor(ssq, 8); ssq += __shfl_xor(ssq, 16); ssq += __shfl_xor(ssq, 32);
        const float rn = rsqrtf(ssq + 1e-12f);
#pragma unroll
        for (int t = 0; t < 2; ++t) {
          const int e0 = (2 * eh + t) * 16 + 4 * quad; const int li = ts * 64 + e0;
          const f32x4 kkn = kkr[t] * rn;
          *(f32x4*)(kkb + li) = kkn; *(f32x4*)(rb + li) = rxv[t]; *(f32x4*)(wb + li) = decv[t]; *(f32x4*)(kab + li) = kkn * axv[t]; *(f32x4*)(kdb + li) = kdv[t]; *(f32x4*)(vb + li) = vxv[t];
          if (PASS_C) *(f32x4*)(yob + li) = yov[t];
        }
        if (PASS_C) {
          bsum += __shfl_xor(bsum, 8); bsum += __shfl_xor(bsum, 16); bsum += __shfl_xor(bsum, 32);
          if (lane < 8) BSg[((size_t)tok * 16 + hd) * 2 + dir] = bsum;
        }
      }
      __builtin_amdgcn_s_waitcnt(0xc07f);
#ifndef NO_STEP
#pragma unroll 1
      for (int s = 0; s < 8; ++s) {
        const f32x4* kk4 = (const f32x4*)(kkb + s * 64);
        f32x2 d0 = (f32x2){0.f, 0.f}, d1 = (f32x2){0.f, 0.f};
#pragma unroll
        for (int q = 0; q < 16; ++q) {
          const f32x4 k4 = kk4[q]; const f32x2 klo = (f32x2){k4[0], k4[1]}, khi = (f32x2){k4[2], k4[3]};
          d0 = __builtin_elementwise_fma(S[2 * q], klo, d0); d1 = __builtin_elementwise_fma(S[2 * q + 1], khi, d1);
          if ((q & 3) == 3) __builtin_amdgcn_sched_barrier(0);
        }
        const float a2 = -((d0[0] + d0[1]) + (d1[0] + d1[1]));
        const float a1 = isP ? 0.f : vb[s * 64 + lane];
        const f32x2 a1v = (f32x2){a1, a1}, a2v = (f32x2){a2, a2};
        const f32x4* w4p = (const f32x4*)(wb + s * 64); const f32x4* ka4p = (const f32x4*)(kab + s * 64);
        const f32x4* kd4p = (const f32x4*)(kdb + s * 64); const f32x4* r4p = (const f32x4*)(rb + s * 64);
        f32x2 y0 = (f32x2){0.f, 0.f}, y1 = (f32x2){0.f, 0.f};
#pragma unroll
        for (int q = 0; q < 16; ++q) {
          const f32x4 w4 = w4p[q], ka4 = ka4p[q], kd4 = kd4p[q];
          const f32x2 wlo = (f32x2){w4[0], w4[1]}, whi = (f32x2){w4[2], w4[3]};
          const f32x2 kalo = (f32x2){ka4[0], ka4[1]}, kahi = (f32x2){ka4[2], ka4[3]};
          const f32x2 kdlo = (f32x2){kd4[0], kd4[1]}, kdhi = (f32x2){kd4[2], kd4[3]};
          f32x2 t0 = a1v * kdlo, t1 = a1v * kdhi;
          t0 = __builtin_elementwise_fma(a2v, kalo, t0); t1 = __builtin_elementwise_fma(a2v, kahi, t1);
          S[2 * q] = __builtin_elementwise_fma(S[2 * q], wlo, t0); S[2 * q + 1] = __builtin_elementwise_fma(S[2 * q + 1], whi, t1);
          if (PASS_C) {
            const f32x4 r4 = r4p[q];
            y0 = __builtin_elementwise_fma(S[2 * q], (f32x2){r4[0], r4[1]}, y0); y1 = __builtin_elementwise_fma(S[2 * q + 1], (f32x2){r4[2], r4[3]}, y1);
          }
          if ((q & 1) == 1) __builtin_amdgcn_sched_barrier(0);
        }
        if (PASS_C) {
          float y = (y0[0] + y0[1]) + (y1[0] + y1[1]);
          const int tok = row0 + sb * 8 + (dir == 0 ? s : 7 - s);
          y += yob[s * 64 + lane];
          Yg[(size_t)tok * 1024 + col] = (h16)y;
        }
      }
#endif
      __syncthreads();
    }
    if (!PASS_C) {
      h16* sp = SUM + ((size_t)(u * 2 + dir) * 2 + (isP ? 1 : 0)) * 4096 + lane * 64;
#pragma unroll
      for (int q = 0; q < 8; ++q) {
        h16x8 sv;
#pragma unroll
        for (int e = 0; e < 4; ++e) { sv[2 * e] = (h16)S[4 * q + e][0]; sv[2 * e + 1] = (h16)S[4 * q + e][1]; }
        *(h16x8*)(sp + 8 * q) = sv;
      }
    }
  }
}


DI float dpp_add(float x, const int ctrl_sel) {
  int xi = __builtin_bit_cast(int, x); int yi;
  if (ctrl_sel == 0) yi = __builtin_amdgcn_mov_dpp(xi, 0xB1, 0xf, 0xf, true);
  else if (ctrl_sel == 1) yi = __builtin_amdgcn_mov_dpp(xi, 0x4E, 0xf, 0xf, true);
  else yi = __builtin_amdgcn_mov_dpp(xi, 0x141, 0xf, 0xf, true);
  return x + __builtin_bit_cast(float, yi);
}
DI float red8(float x) { x = dpp_add(x, 0); x = dpp_add(x, 1); x = dpp_add(x, 2); return x; }

struct ScanPre { h16x8 bw[2], ba[2]; h16x4 k4, r4, v4; };

DI void phase_scan_seq(const Params& p, char* smem) {
  int tid_ = threadIdx.x; asm volatile("" : "+v"(tid_));
  const int tid = tid_, lane = tid & 63, w = tid >> 6;
  float* fb = (float*)smem;
  float* part = fb + 2 * 6144;
  float* partb = part + 128;
  float* ybuf = partb + 128;
  const h16* Rg = (const h16*)(p.ws + OFF_R); const h16* Kg = (const h16*)(p.ws + OFF_K); const h16* Vg = (const h16*)(p.ws + OFF_V);
  const h16* TWg = (const h16*)(p.ws + OFF_TW); const h16* TAg = (const h16*)(p.ws + OFF_TA);
  float* BSg = (float*)(p.ws + OFF_BS);
  const int ts = lane & 15, quad = lane >> 4;
  const int rowl = w * 16 + (lane >> 2), kq = lane & 3;
  constexpr int NST = 528;
  for (int u = blockIdx.x; u < 256; u += gridDim.x) {
    const int chain = u, dir = chain & 1, bh = chain >> 1, b = bh >> 4, hd = bh & 15;
    h16* Yg = (h16*)(p.ws + (dir == 0 ? OFF_H : OFF_Y1));
    const int e0 = 16 * w + 4 * quad;
    const int c0 = hd * 64 + e0;
    h16x8 aw[2], aa[2];
    {
      const h16* W2Tw = (const h16*)((const u16*)(p.ws + OFF_W) + W_L2W) + (size_t)dir * 1024 * 64 + (size_t)(hd * 64 + 16 * w + ts) * 64 + 8 * quad;
      const h16* W2Ta = (const h16*)((const u16*)(p.ws + OFF_W) + W_L2A) + (size_t)dir * 1024 * 64 + (size_t)(hd * 64 + 16 * w + ts) * 64 + 8 * quad;
      aw[0] = *(const h16x8*)W2Tw; aw[1] = *(const h16x8*)(W2Tw + 32); aa[0] = *(const h16x8*)W2Ta; aa[1] = *(const h16x8*)(W2Ta + 32);
    }
    const f32x4 w0c = *(const f32x4*)(p.rwkv_w0 + dir * 1024 + c0), a0c = *(const f32x4*)(p.rwkv_a0 + dir * 1024 + c0);
    const f32x4 kkc = *(const f32x4*)(p.rwkv_k_k + c0), kac = *(const f32x4*)(p.rwkv_k_a + c0), rkc = *(const f32x4*)(p.rwkv_r_k + c0);
    auto stage_row = [&](int st) -> int {
      if (st < 16) return T + b * CTXL + (dir == 0 ? st : 15 - st) * 16;
      const int q = st - 16; return b * SEQ + (dir == 0 ? q : 511 - q) * 16;
    };
    auto pre_load = [&](int st) -> ScanPre {
      ScanPre pr; const int tok = stage_row(st) + (dir == 0 ? ts : 15 - ts);
      const h16* twp = TWg + (size_t)tok * 128 + dir * 64 + 8 * quad; const h16* tap = TAg + (size_t)tok * 128 + dir * 64 + 8 * quad;
      pr.bw[0] = *(const h16x8*)twp; pr.bw[1] = *(const h16x8*)(twp + 32); pr.ba[0] = *(const h16x8*)tap; pr.ba[1] = *(const h16x8*)(tap + 32);
      const size_t gi = (size_t)tok * 1024 + c0;
      pr.k4 = *(const h16x4*)(Kg + gi); pr.r4 = *(const h16x4*)(Rg + gi); pr.v4 = *(const h16x4*)(Vg + gi);
      return pr;
    };
    auto pre_compute = [&](const ScanPre& pr, int buf) {
      f32x4 cw = (f32x4){0.f, 0.f, 0.f, 0.f}, ca = (f32x4){0.f, 0.f, 0.f, 0.f};
#pragma unroll
      for (int ks = 0; ks < 2; ++ks) { cw = __builtin_amdgcn_mfma_f32_16x16x32_f16(aw[ks], pr.bw[ks], cw, 0, 0, 0); ca = __builtin_amdgcn_mfma_f32_16x16x32_f16(aa[ks], pr.ba[ks], ca, 0, 0, 0); }
      float* B = fb + buf * 6144 + ts * 64 + e0;
      f32x4 kkr, rx, vx, dec, kar, kd; float ssq = 0.f, bsum = 0.f;
#pragma unroll
      for (int e = 0; e < 4; ++e) {
        const float wl = cw[e] + w0c[e], al = ca[e] + a0c[e];
        const float kx = (float)pr.k4[e]; rx[e] = (float)pr.r4[e]; vx[e] = (float)pr.v4[e];
        const float kr = kx * kkc[e]; kkr[e] = kr; ssq += kr * kr;
        const float nx = -wl; const float sp = fmaxf(nx, 0.f) + __logf(1.0f + __expf(-fabsf(nx)));
        dec[e] = __expf(-__expf(-sp - 0.5f));
        const float ax = sigmoidf_(al);
        kd[e] = kx * (1.0f + (ax - 1.0f) * kac[e]); kar[e] = kr * ax;
        bsum += rx[e] * kd[e] * rkc[e];
      }
      *(f32x4*)(B) = kkr; *(f32x4*)(B + 1024) = rx; *(f32x4*)(B + 2048) = dec; *(f32x4*)(B + 3072) = kar; *(f32x4*)(B + 4096) = kd; *(f32x4*)(B + 5120) = vx;
      ssq += __shfl_xor(ssq, 16); ssq += __shfl_xor(ssq, 32);
      bsum += __shfl_xor(bsum, 16); bsum += __shfl_xor(bsum, 32);
      if (lane < 16) { part[(buf * 16 + ts) * 4 + w] = ssq; partb[(buf * 16 + ts) * 4 + w] = bsum; }
    };
    f32x2 S[8];
#pragma unroll
    for (int i = 0; i < 8; ++i) S[i] = (f32x2){0.f, 0.f};
    __syncthreads();
    { const ScanPre pr = pre_load(0); pre_compute(pr, 0); }
    __syncthreads();
#pragma unroll 1
    for (int st = 0; st < NST; ++st) {
      const int cur = st & 1;
      ScanPre pr; const bool more = st + 1 < NST;
      if (more) pr = pre_load(st + 1);
      if (tid < 16) {
        const f32x4 pb = *(const f32x4*)(partb + (cur * 16 + tid) * 4);
        const int tok = stage_row(st) + (dir == 0 ? tid : 15 - tid);
        BSg[((size_t)tok * 16 + hd) * 2 + dir] = (pb[0] + pb[1]) + (pb[2] + pb[3]);
      }
      const float* B = fb + cur * 6144;
      float* yb = ybuf + cur * 1024;
#pragma unroll 8
      for (int s = 0; s < 16; ++s) {
        const float* Bs = B + s * 64 + 16 * kq;
        f32x4 kk[4], ww[4], ka[4], kd[4], rr[4];
#pragma unroll
        for (int q = 0; q < 4; ++q) { kk[q] = *(const f32x4*)(Bs + 4 * q); ww[q] = *(const f32x4*)(Bs + 2048 + 4 * q); ka[q] = *(const f32x4*)(Bs + 3072 + 4 * q); kd[q] = *(const f32x4*)(Bs + 4096 + 4 * q); rr[q] = *(const f32x4*)(Bs + 1024 + 4 * q); }
        const f32x4 pr4 = *(const f32x4*)(part + (cur * 16 + s) * 4);
        const float a1 = B[5120 + s * 64 + rowl];
        f32x2 d0 = S[0] * (f32x2){kk[0][0], kk[0][1]}, d1 = S[1] * (f32x2){kk[0][2], kk[0][3]};
#pragma unroll
        for (int q = 1; q < 4; ++q) { d0 = __builtin_elementwise_fma(S[2 * q], (f32x2){kk[q][0], kk[q][1]}, d0); d1 = __builtin_elementwise_fma(S[2 * q + 1], (f32x2){kk[q][2], kk[q][3]}, d1); }
        float x = (d0[0] + d0[1]) + (d1[0] + d1[1]); x = dpp_add(x, 0); x = dpp_add(x, 1);
        const float rn2 = __builtin_amdgcn_rcpf((pr4[0] + pr4[1]) + (pr4[2] + pr4[3]) + 1e-12f);
        const float a2 = -x * rn2;
        const f32x2 a1v = (f32x2){a1, a1}, a2v = (f32x2){a2, a2};
        f32x2 y0 = (f32x2){0.f, 0.f}, y1 = (f32x2){0.f, 0.f};
#pragma unroll
        for (int q = 0; q < 4; ++q) {
          f32x2 t0 = __builtin_elementwise_fma(a2v, (f32x2){ka[q][0], ka[q][1]}, a1v * (f32x2){kd[q][0], kd[q][1]});
          f32x2 t1 = __builtin_elementwise_fma(a2v, (f32x2){ka[q][2], ka[q][3]}, a1v * (f32x2){kd[q][2], kd[q][3]});
          S[2 * q] = __builtin_elementwise_fma(S[2 * q], (f32x2){ww[q][0], ww[q][1]}, t0);
          S[2 * q + 1] = __builtin_elementwise_fma(S[2 * q + 1], (f32x2){ww[q][2], ww[q][3]}, t1);
          y0 = __builtin_elementwise_fma(S[2 * q], (f32x2){rr[q][0], rr[q][1]}, y0);
          y1 = __builtin_elementwise_fma(S[2 * q + 1], (f32x2){rr[q][2], rr[q][3]}, y1);
        }
        float y = (y0[0] + y0[1]) + (y1[0] + y1[1]); y = dpp_add(y, 0); y = dpp_add(y, 1);
        if (kq == 0) yb[s * 64 + rowl] = y;
      }
      if (more) pre_compute(pr, cur ^ 1);
      __syncthreads();
#pragma unroll
      for (int hh = 0; hh < 4; ++hh) { const int s = (tid >> 6) + 4 * hh, vl = tid & 63; const int tok = stage_row(st) + (dir == 0 ? s : 15 - s);
        Yg[(size_t)tok * 1024 + hd * 64 + vl] = (h16)yb[s * 64 + vl]; }
    }
    __syncthreads();
  }
}

DI void phase_combine(const Params& p, char* smem) {
  const int tid = threadIdx.x, v = tid >> 2, kq = tid & 3;
  float* curs = (float*)smem;
  float* Ps = (float*)(smem + 64 * 68 * 4);
  h16* SUM = (h16*)(p.ws + OFF_SUMM);
  for (int cidx = blockIdx.x; cidx < 256; cidx += gridDim.x) {
    const int dir = cidx & 1, bh = cidx >> 1;
    float cur[16];
#pragma unroll
    for (int e = 0; e < 16; ++e) cur[e] = 0.f;
    for (int i = 0; i < 33; ++i) {
      const int ch = i == 0 ? 0 : (dir == 0 ? i : 33 - i);
      const int u = bh * 33 + ch;
      h16* sp = SUM + ((size_t)(u * 2 + dir) * 2) * 4096;
      const h16x8 se0 = *(const h16x8*)(sp + v * 64 + kq * 16), se1 = *(const h16x8*)(sp + v * 64 + kq * 16 + 8);
      const h16x8 pe0 = *(const h16x8*)(sp + 4096 + v * 64 + kq * 16), pe1 = *(const h16x8*)(sp + 4096 + v * 64 + kq * 16 + 8);
      __syncthreads();
      h16x8 c0, c1;
#pragma unroll
      for (int e = 0; e < 8; ++e) { c0[e] = (h16)cur[e]; c1[e] = (h16)cur[8 + e]; curs[v * 68 + kq * 16 + e] = cur[e]; curs[v * 68 + kq * 16 + 8 + e] = cur[8 + e];
        Ps[v * 64 + kq * 16 + e] = (float)pe0[e]; Ps[v * 64 + kq * 16 + 8 + e] = (float)pe1[e]; }
      *(h16x8*)(sp + v * 64 + kq * 16) = c0; *(h16x8*)(sp + v * 64 + kq * 16 + 8) = c1;
      __syncthreads();
      float nw[16];
#pragma unroll
      for (int e = 0; e < 8; ++e) { nw[e] = (float)se0[e]; nw[8 + e] = (float)se1[e]; }
      for (int jj = 0; jj < 64; jj += 4) {
        const f32x4 cv = *(const f32x4*)(curs + v * 68 + jj);
#pragma unroll
        for (int e4 = 0; e4 < 4; ++e4) {
          const float cs = cv[e4];
#pragma unroll
          for (int q = 0; q < 4; ++q) { const f32x4 pv = *(const f32x4*)(Ps + (jj + e4) * 64 + kq * 16 + 4 * q);
#pragma unroll
            for (int e = 0; e < 4; ++e) nw[4 * q + e] += cs * pv[e]; }
        }
      }
#pragma unroll
      for (int e = 0; e < 16; ++e) cur[e] = nw[e];
    }
    __syncthreads();
  }
}

DI void phase_rwkv_ln(const Params& p) {
  const int lane = threadIdx.x & 63, w = threadIdx.x >> 6, hd = lane >> 2;
  const h16* Yg = (const h16*)(p.ws + OFF_H); const h16* Y1g = (const h16*)(p.ws + OFF_Y1); const h16* Vg = (const h16*)(p.ws + OFF_V);
  h16* Zg = (h16*)(p.ws + OFF_Z); const float* BSg = (const float*)(p.ws + OFF_BS);
  const int c0 = lane * 16;
  for (int row = blockIdx.x * 4 + w; row < MALL; row += gridDim.x * 4) {
    const size_t gi = (size_t)row * 1024 + c0;
    float y[16], vv[16], zz[16];
#pragma unroll
    for (int q = 0; q < 2; ++q) { const h16x8 a = *(const h16x8*)(Yg + gi + 8 * q), a1 = *(const h16x8*)(Y1g + gi + 8 * q), b = *(const h16x8*)(Vg + gi + 8 * q), c = *(const h16x8*)(Zg + gi + 8 * q);
#pragma unroll
      for (int e = 0; e < 8; ++e) { y[8 * q + e] = (float)a[e] + (float)a1[e]; vv[8 * q + e] = (float)b[e]; zz[8 * q + e] = (float)c[e]; } }
    float s = 0.f;
#pragma unroll
    for (int e = 0; e < 16; ++e) s += y[e];
    s += __shfl_xor(s, 1); s += __shfl_xor(s, 2);
    const float mean = s * (1.0f / 64.0f);
    float q2 = 0.f;
#pragma unroll
    for (int e = 0; e < 16; ++e) { const float d = y[e] - mean; q2 += d * d; }
    q2 += __shfl_xor(q2, 1); q2 += __shfl_xor(q2, 2);
    const float rstd = rsqrtf(q2 * (1.0f / 64.0f) + 64e-5f);
    const float bon = BSg[((size_t)row * 16 + hd) * 2] + BSg[((size_t)row * 16 + hd) * 2 + 1];
    unsigned o[8];
    f32x4 gq[4], bq[4];
#pragma unroll
    for (int q = 0; q < 4; ++q) { gq[q] = *(const f32x4*)(p.rwkv_ln_gain + c0 + 4 * q); bq[q] = *(const f32x4*)(p.rwkv_ln_bias + c0 + 4 * q); }
#pragma unroll
    for (int e = 0; e < 8; ++e) {
      const int i0 = 2 * e, i1 = 2 * e + 1;
      float t0 = (y[i0] - mean) * rstd * gq[i0 >> 2][i0 & 3] + bq[i0 >> 2][i0 & 3] + bon * vv[i0];
      float t1 = (y[i1] - mean) * rstd * gq[i1 >> 2][i1 & 3] + bq[i1 >> 2][i1 & 3] + bon * vv[i1];
      o[e] = pack2bf(t0 * siluf_(zz[i0]), t1 * siluf_(zz[i1]));
    }
    u32x4* op = (u32x4*)(Zg + gi);
    op[0] = (u32x4){o[0], o[1], o[2], o[3]}; op[1] = (u32x4){o[4], o[5], o[6], o[7]};
  }
}

struct EpiMlaIn {
  const Params* p; int m0, nt;
  DI void operator()(const f32x16 (&acc)[4], int w, int r, int h) const {
    const int row = m0 + 32 * w + r;
    if (nt < 8) {
      float ss = 0.f;
      u16* O = nt < 6 ? (u16*)(p->ws + OFF_CQ) + (size_t)row * 768 + nt * 128 : (u16*)(p->ws + OFF_CKV) + (size_t)row * 256 + (nt - 6) * 128;
#pragma unroll
      for (int ni = 0; ni < 4; ++ni)
#pragma unroll
        for (int q = 0; q < 4; ++q) {
          const float a0 = acc[ni][4 * q], a1 = acc[ni][4 * q + 1], a2 = acc[ni][4 * q + 2], a3 = acc[ni][4 * q + 3];
          ss += a0 * a0 + a1 * a1 + a2 * a2 + a3 * a3;
          *(u32x2*)(O + 32 * ni + 8 * q + 4 * h) = (u32x2){pack2bf(a0, a1), pack2bf(a2, a3)};
        }
      ss += __shfl_xor(ss, 32);
      if (h == 0) atomicAdd((float*)(p->ws + (nt < 6 ? OFF_SSQA : OFF_SSQB)) + row, ss);
    } else if (nt < 24) {
      u16* O = (u16*)(p->ws + OFF_SZ) + (size_t)row * 2048 + (nt - 8) * 128;
#pragma unroll
      for (int ni = 0; ni < 4; ++ni)
#pragma unroll
        for (int q = 0; q < 4; ++q)
          *(u32x2*)(O + 32 * ni + 8 * q + 4 * h) = (u32x2){pack2bf(siluf_(acc[ni][4 * q]), siluf_(acc[ni][4 * q + 1])), pack2bf(siluf_(acc[ni][4 * q + 2]), siluf_(acc[ni][4 * q + 3]))};
    } else {
      float* O = (float*)(p->ws + OFF_KR) + (size_t)row * 64; float ss = 0.f;
#pragma unroll
      for (int ni = 0; ni < 2; ++ni)
#pragma unroll
        for (int q = 0; q < 4; ++q) {
          f32x4 o;
#pragma unroll
          for (int e = 0; e < 4; ++e) { o[e] = acc[ni][4 * q + e]; ss += o[e] * o[e]; }
          *(f32x4*)(O + 32 * ni + 8 * q + 4 * h) = o;
        }
      ss += __shfl_xor(ss, 32);
      if (h == 0) ((float*)(p->ws + OFF_SSQR))[row] = ss;
    }
  }
};
DI void phase_mla_in(const Params& p, char* smem) {
  const u16* H = (const u16*)(p.ws + OFF_H);
  const u16* Wt = (const u16*)(p.ws + OFF_W) + W_MIN;
  for (int vb = blockIdx.x; (vb >> 3) < 803; vb += gridDim.x) {
    const int xcd = vb & 7, lg = vb >> 3;
    int mt, nt;
    if (lg < 768) { mt = lg / 3; nt = xcd + 8 * (lg % 3); }
    else if (lg < 800) { mt = (lg - 768) * 8 + xcd; nt = 24; }
    else { const int q = (lg - 800) * 8 + xcd; mt = 256 + q / 3; const int s = q % 3; nt = s == 0 ? 6 : (s == 1 ? 7 : 24); }
    EpiMlaIn ep{&p, mt * 256, nt};
    gemm_tile_glds(H + (size_t)mt * 256 * D, D, Wt + (size_t)nt * 128 * D, D, D, ep, smem);
  }
}

constexpr float QSCALE = 0.07216878364870322f * 1.4426950408889634f;
struct EpiMlaQ {
  const Params* p; int grow0  , lrow0  , head;
  DI void operator()(const f32x16 (&acc)[6], int w, int r, int h) const {
    const int row = grow0 + 32 * w + r, lrow = lrow0 + 32 * w + r;
    const float rq = rsqrtf(((const float*)(p->ws + OFF_SSQA))[row] * (1.0f / 768.0f) + 1e-6f);
    float ss = 0.f;
#pragma unroll
    for (int ni = 0; ni < 6; ++ni)
#pragma unroll
      for (int i = 0; i < 16; ++i) { const float v = acc[ni][i] * rq; ss += v * v; }
    ss += __shfl_xor(ss, 32);
    const float sc = rq * rsqrtf(ss * (1.0f / 192.0f) + 1e-6f) * QSCALE;
    const float* gq = p->mla_qk_gain_q;
    u16* O = (u16*)(p->ws + OFF_QX) + ((size_t)lrow * 16 + head) * 256;
#pragma unroll
    for (int ni = 0; ni < 4; ++ni)
#pragma unroll
      for (int q = 0; q < 4; ++q) {
        const int n = 32 * ni + 8 * q + 4 * h; const f32x4 g = *(const f32x4*)(gq + n);
        *(u32x2*)(O + n) = (u32x2){pack2bf(acc[ni][4 * q] * sc * g[0], acc[ni][4 * q + 1] * sc * g[1]), pack2bf(acc[ni][4 * q + 2] * sc * g[2], acc[ni][4 * q + 3] * sc * g[3])};
      }
    const int pos = row & (SEQ - 1); const int prow = pos >> 6, pcol = pos & 63;
    const f32x2* cs = (const f32x2*)(p->ws + OFF_CS);
#pragma unroll
    for (int q = 0; q < 4; ++q) {
      const int pb = 8 * q + 4 * h;
      float x1[4], x2[4], o1[4], o2[4];
#pragma unroll
      for (int e = 0; e < 4; ++e) {
        const int pi = pb + e;
        x1[e] = acc[4][4 * q + e] * sc * gq[128 + pi]; x2[e] = acc[5][4 * q + e] * sc * gq[160 + pi];
        const f32x2 c = pi < 16 ? cs[prow * 16 + pi] : cs[2048 + pcol * 16 + (pi - 16)];
        o1[e] = x1[e] * c[0] - x2[e] * c[1]; o2[e] = x1[e] * c[1] + x2[e] * c[0];
      }
      *(u32x2*)(O + 128 + pb) = (u32x2){pack2bf(o1[0], o1[1]), pack2bf(o1[2], o1[3])};
      *(u32x2*)(O + 160 + pb) = (u32x2){pack2bf(o2[0], o2[1]), pack2bf(o2[2], o2[3])};
      *(u32x2*)(O + 192 + pb) = (u32x2){pack2bf(x1[0], x1[1]), pack2bf(x1[2], x1[3])};
      *(u32x2*)(O + 224 + pb) = (u32x2){pack2bf(x2[0], x2[1]), pack2bf(x2[2], x2[3])};
    }
  }
};
struct EpiMlaKV {
  const Params* p; int grow0, kvrow0  , head, isv, blocal;
  DI void operator()(const f32x16 (&acc)[4], int w, int r, int h) const {
    const int row = grow0 + 32 * w + r, kvrow = kvrow0 + 32 * w + r;
    const float rkv = rsqrtf(((const float*)(p->ws + OFF_SSQB))[row] * (1.0f / 256.0f) + 1e-6f);
    if (isv) {
      u16* O = (u16*)(p->ws + OFF_VT) + ((size_t)(blocal * 16 + head) * 128) * 8448 + (kvrow - blocal * 8448);
#pragma unroll
      for (int ni = 0; ni < 4; ++ni)
#pragma unroll
        for (int i = 0; i < 16; ++i) O[(size_t)(32 * ni + crow(i, h)) * 8448] = f2bf(acc[ni][i] * rkv);
      return;
    }
    float ss = 0.f;
#pragma unroll
    for (int ni = 0; ni < 4; ++ni)
#pragma unroll
      for (int i = 0; i < 16; ++i) { const float v = acc[ni][i] * rkv; ss += v * v; }
    ss += __shfl_xor(ss, 32);
    ss += ((const float*)(p->ws + OFF_SSQR))[row];
    const float rn = rsqrtf(ss * (1.0f / 192.0f) + 1e-6f); const float sc = rkv * rn;
    const float* gk = p->mla_qk_gain_k;
    u16* O = (u16*)(p->ws + OFF_KX) + ((size_t)kvrow * 16 + head) * 192;
#pragma unroll
    for (int ni = 0; ni < 4; ++ni)
#pragma unroll
      for (int q = 0; q < 4; ++q) {
        const int n = 32 * ni + 8 * q + 4 * h; const f32x4 g = *(const f32x4*)(gk + n);
        *(u32x2*)(O + n) = (u32x2){pack2bf(acc[ni][4 * q] * sc * g[0], acc[ni][4 * q + 1] * sc * g[1]), pack2bf(acc[ni][4 * q + 2] * sc * g[2], acc[ni][4 * q + 3] * sc * g[3])};
      }
    const float* kr = (const float*)(p->ws + OFF_KR) + (size_t)row * 64;
    const bool lat = row < T; const int pos = row & (SEQ - 1);
    const f32x2* cs = (const f32x2*)(p->ws + OFF_CS) + (h == 0 ? (pos >> 6) * 16 : 2048 + (pos & 63) * 16);
    unsigned o1[8], o2[8];
#pragma unroll
    for (int e = 0; e < 8; ++e) {
      float a[2], b[2];
#pragma unroll
      for (int t = 0; t < 2; ++t) {
        const int pi = 16 * h + 2 * e + t;
        const float x1 = kr[pi] * rn * gk[128 + pi], x2 = kr[32 + pi] * rn * gk[160 + pi];
        f32x2 c = (f32x2){1.f, 0.f}; if (lat) c = cs[2 * e + t];
        a[t] = x1 * c[0] - x2 * c[1]; b[t] = x1 * c[1] + x2 * c[0];
      }
      o1[e] = pack2bf(a[0], a[1]); o2[e] = pack2bf(b[0], b[1]);
    }
    u32x4* d1 = (u32x4*)(O + 128 + 16 * h); u32x4* d2 = (u32x4*)(O + 160 + 16 * h);
    d1[0] = (u32x4){o1[0], o1[1], o1[2], o1[3]}; d1[1] = (u32x4){o1[4], o1[5], o1[6], o1[7]};
    d2[0] = (u32x4){o2[0], o2[1], o2[2], o2[3]}; d2[1] = (u32x4){o2[4], o2[5], o2[6], o2[7]};
  }
};
DI void phase_mla_up(const Params& p, int g, char* smem) {
  const u16* W = (const u16*)(p.ws + OFF_W);
  const int nq = 128 * 16, nkv = 132 * 32;
  for (int t = blockIdx.x; t < nq + nkv; t += gridDim.x) {
    if (t < nq) {
      const int mt = t >> 4, head = t & 15;
      const int grow0 = g * 16384 + mt * 128;
      XPlain xl{(const u16*)(p.ws + OFF_CQ) + (size_t)grow0 * 768, 768};
      EpiMlaQ ep{&p, grow0, mt * 128, head};
      gemm_tile<1, 6>(xl, W + W_UQ + (size_t)head * 192 * 768, 768, 768, ep, smem);
    } else {
      const int q = t - nq; const int mt = q >> 5, nt = q & 31;
      int grow0, kvrow0, blocal;
      if (mt < 128) { blocal = mt >> 6; grow0 = g * 16384 + mt * 128; kvrow0 = blocal * 8448 + 256 + (mt & 63) * 128; }
      else { const int cm = mt - 128; blocal = cm >> 1; grow0 = T + (g * 2 + blocal) * 256 + (cm & 1) * 128; kvrow0 = blocal * 8448 + (cm & 1) * 128; }
      XPlain xl{(const u16*)(p.ws + OFF_CKV) + (size_t)grow0 * 256, 256};
      EpiMlaKV ep{&p, grow0, kvrow0, nt >> 1, nt & 1, blocal};
      gemm_tile<1, 4>(xl, W + W_UKV + (size_t)nt * 128 * 256, 256, 256, ep, smem);
    }
  }
}

DI int kswap(int r) { return (r & ~12) | ((r & 4) << 1) | ((r & 8) >> 1); }
constexpr int KROW = 400;
DI void phase_attn(const Params& p, int g, char* smem, bool dry = false) {
  int tid_ = threadIdx.x; asm volatile("" : "+v"(tid_));
  const int tid = tid_, lane = tid & 63, w = tid >> 6, r = lane & 31, h = lane >> 5;
  char* Ks = smem; char* Vs = smem + 64 * KROW;
  const u16* QX = (const u16*)(p.ws + OFF_QX); const u16* KX = (const u16*)(p.ws + OFF_KX); const u16* VT = (const u16*)(p.ws + OFF_VT);
  u16* SZ = (u16*)(p.ws + OFF_SZ);
  const int ksr = kswap(r);
  for (int uu = blockIdx.x; uu < 2048; uu += gridDim.x) {
    const int xcd = uu & 7, lg = uu >> 3; const int bh = (lg >> 6) * 8 + xcd;
    const int qb = lg & 63, head = bh & 15, blocal = bh >> 4;
    const int lq = blocal * 8192 + qb * 128 + 32 * w + r;
    const u16* qp = QX + ((size_t)lq * 16 + head) * 256;
    bf16x8 qf[12];
#pragma unroll
    for (int ds = 0; ds < 8; ++ds) qf[ds] = *(const bf16x8*)(qp + 16 * ds + 8 * h);
#pragma unroll
    for (int ds = 0; ds < 4; ++ds) qf[8 + ds] = *(const bf16x8*)(qp + 192 + 16 * ds + 8 * h);
    f32x16 O[4];
#pragma unroll
    for (int di = 0; di < 4; ++di)
#pragma unroll
      for (int i = 0; i < 16; ++i) O[di][i] = 0.f;
    float m = -1e30f, l = 0.f;
    const u16* kbase = KX + ((size_t)blocal * 8448 * 16 + head) * 192;
    const u16* vbase = VT + (size_t)(blocal * 16 + head) * 128 * 8448;
    u32x4 kr_[6], vr_[4];
    const u16* kptr = kbase + (size_t)(tid >> 2) * 3072 + (tid & 3) * 8;
    const u16* vptr = vbase + (size_t)(tid >> 1) * 8448 + (tid & 1) * 32;
    char* kls = Ks + (tid >> 2) * KROW + (tid & 3) * 16;
    char* vls = Vs + (tid >> 1) * LROW + (tid & 1) * 64;
#pragma unroll
    for (int j = 0; j < 6; ++j) kr_[j] = *(const u32x4*)(kptr + 32 * j);
#pragma unroll
    for (int j = 0; j < 4; ++j) vr_[j] = *(const u32x4*)(vptr + 8 * j);
#pragma unroll 1
    for (int kt = 0; kt < 132; ++kt) {
      __syncthreads();
#pragma unroll
      for (int j = 0; j < 6; ++j) *(u32x4*)(kls + 64 * j) = kr_[j];
#pragma unroll
      for (int j = 0; j < 4; ++j) *(u32x4*)(vls + 16 * j) = vr_[j];
      __syncthreads();
      if (kt + 1 < 132) {
        kptr += 64 * 3072; vptr += 64;
#pragma unroll
        for (int j = 0; j < 6; ++j) kr_[j] = *(const u32x4*)(kptr + 32 * j);
#pragma unroll
        for (int j = 0; j < 4; ++j) vr_[j] = *(const u32x4*)(vptr + 8 * j);
      }
      if (kt == 4) {
#pragma unroll
        for (int ds = 0; ds < 4; ++ds) qf[8 + ds] = *(const bf16x8*)(qp + 128 + 16 * ds + 8 * h);
      }
      f32x16 St[2];
      __builtin_amdgcn_s_setprio(1);
#pragma unroll
      for (int kb = 0; kb < 2; ++kb) {
#pragma unroll
        for (int i = 0; i < 16; ++i) St[kb][i] = 0.f;
#pragma unroll
        for (int ds = 0; ds < 12; ++ds) {
          const bf16x8 kf = *(const bf16x8*)(Ks + (32 * kb + ksr) * KROW + (16 * ds + 8 * h) * 2);
          St[kb] = MFMA(kf, qf[ds], St[kb]);
          if ((ds & 3) == 3) __builtin_amdgcn_sched_barrier(0);
        }
      }
      __builtin_amdgcn_s_setprio(0);
      asm volatile("s_nop 7\n\ts_nop 7" ::: "memory");
      float mx = St[0][0];
#pragma unroll
      for (int kb = 0; kb < 2; ++kb)
#pragma unroll
        for (int i = 0; i < 16; ++i) mx = fmaxf(mx, St[kb][i]);
      mx = fmaxf(mx, __shfl_xor(mx, 32));
      const float mn = fmaxf(m, mx); const float alpha = __builtin_amdgcn_exp2f(m - mn); m = mn;
      St[0] = St[0] - mn; St[1] = St[1] - mn;
#pragma unroll
      for (int kb = 0; kb < 2; ++kb)
#pragma unroll
        for (int i = 0; i < 16; ++i) St[kb][i] = __builtin_amdgcn_exp2f(St[kb][i]);
      float ls;
      { const f32x16 t = St[0] + St[1];
        const f32x4 a = (f32x4){t[0], t[1], t[2], t[3]} + (f32x4){t[4], t[5], t[6], t[7]} + (f32x4){t[8], t[9], t[10], t[11]} + (f32x4){t[12], t[13], t[14], t[15]};
        ls = (a[0] + a[1]) + (a[2] + a[3]); }
      l = l * alpha + ls;
      if (__builtin_amdgcn_ballot_w64(alpha != 1.0f) != 0ull) {
#pragma unroll
        for (int di = 0; di < 4; ++di)
#pragma unroll
          for (int i = 0; i < 16; ++i) O[di][i] *= alpha;
      }
      __builtin_amdgcn_s_setprio(1);
#pragma unroll
      for (int kb = 0; kb < 2; ++kb)
#pragma unroll
        for (int s = 0; s < 2; ++s) {
          u32x4 pk;
#pragma unroll
          for (int e = 0; e < 4; ++e) pk[e] = pack2bf(St[kb][8 * s + 2 * e], St[kb][8 * s + 2 * e + 1]);
          const bf16x8 pf = __builtin_bit_cast(bf16x8, pk);
#pragma unroll
          for (int di = 0; di < 4; ++di) {
            const bf16x8 vf = *(const bf16x8*)(Vs + (32 * di + r) * LROW + (32 * kb + 16 * s + 8 * h) * 2);
            O[di] = MFMA(vf, pf, O[di]);
          }
          __builtin_amdgcn_sched_barrier(0);
        }
      __builtin_amdgcn_s_setprio(0);
      asm volatile("s_nop 7\n\ts_nop 7" ::: "memory");
    }
    l += __shfl_xor(l, 32);
    const float inv = 1.0f / l;
    const int grow = g * 16384 + lq;
    u16* op = SZ + (size_t)grow * 2048 + head * 128;
    if (dry && l > 0.f) continue;
#pragma unroll
    for (int di = 0; di < 4; ++di)
#pragma unroll
      for (int q = 0; q < 4; ++q) {
        const int n = 32 * di + 8 * q + 4 * h;
        const u32x2 z = *(const u32x2*)(op + n);
        *(u32x2*)(op + n) = (u32x2){pack2bf(O[di][4 * q] * inv * bflo(z[0]), O[di][4 * q + 1] * inv * bfhi(z[0])), pack2bf(O[di][4 * q + 2] * inv * bflo(z[1]), O[di][4 * q + 3] * inv * bfhi(z[1]))};
      }
  }
}

typedef const volatile __attribute__((address_space(4))) unsigned long long* kargp_t;
DI Params ldp() {
  kargp_t kp = (kargp_t)__builtin_amdgcn_kernarg_segment_ptr();
  Params q;
  q.x = (const float*)(const __attribute__((address_space(1))) float*)kp[0];
  q.c = (const float*)(const __attribute__((address_space(1))) float*)kp[1];
  q.ctx = (const float*)(const __attribute__((address_space(1))) float*)kp[2];
  q.c_ctx = (const float*)(const __attribute__((address_space(1))) float*)kp[3];
  q.ada_w = (const float*)(const __attribute__((address_space(1))) float*)kp[4];
  q.ada_b = (const float*)(const __attribute__((address_space(1))) float*)kp[5];
  q.sgu_w_in = (const float*)(const __attribute__((address_space(1))) float*)kp[6];
  q.sgu_gain = (const float*)(const __attribute__((address_space(1))) float*)kp[7];
  q.sgu_w_s = (const float*)(const __attribute__((address_space(1))) float*)kp[8];
  q.sgu_b_s = (const float*)(const __attribute__((address_space(1))) float*)kp[9];
  q.sgu_w_out = (const float*)(const __attribute__((address_space(1))) float*)kp[10];
  q.rwkv_mu = (const float*)(const __attribute__((address_space(1))) float*)kp[11];
  q.rwkv_w_in = (const float*)(const __attribute__((address_space(1))) float*)kp[12];
  q.rwkv_w_lora1 = (const float*)(const __attribute__((address_space(1))) float*)kp[13];
  q.rwkv_w_lora2 = (const float*)(const __attribute__((address_space(1))) float*)kp[14];
  q.rwkv_w0 = (const float*)(const __attribute__((address_space(1))) float*)kp[15];
  q.rwkv_a_lora1 = (const float*)(const __attribute__((address_space(1))) float*)kp[16];
  q.rwkv_a_lora2 = (const float*)(const __attribute__((address_space(1))) float*)kp[17];
  q.rwkv_a0 = (const float*)(const __attribute__((address_space(1))) float*)kp[18];
  q.rwkv_k_k = (const float*)(const __attribute__((address_space(1))) float*)kp[19];
  q.rwkv_k_a = (const float*)(const __attribute__((address_space(1))) float*)kp[20];
  q.rwkv_r_k = (const float*)(const __attribute__((address_space(1))) float*)kp[21];
  q.rwkv_ln_gain = (const float*)(const __attribute__((address_space(1))) float*)kp[22];
  q.rwkv_ln_bias = (const float*)(const __attribute__((address_space(1))) float*)kp[23];
  q.rwkv_w_out = (const float*)(const __attribute__((address_space(1))) float*)kp[24];
  q.mla_w_in = (const float*)(const __attribute__((address_space(1))) float*)kp[25];
  q.mla_q_norm = (const float*)(const __attribute__((address_space(1))) float*)kp[26];
  q.mla_kv_norm = (const float*)(const __attribute__((address_space(1))) float*)kp[27];
  q.mla_w_uq = (const float*)(const __attribute__((address_space(1))) float*)kp[28];
  q.mla_w_ukv = (const float*)(const __attribute__((address_space(1))) float*)kp[29];
  q.mla_qk_gain_q = (const float*)(const __attribute__((address_space(1))) float*)kp[30];
  q.mla_qk_gain_k = (const float*)(const __attribute__((address_space(1))) float*)kp[31];
  q.mla_w_out = (const float*)(const __attribute__((address_space(1))) float*)kp[32];
  q.out = (float*)(__attribute__((address_space(1))) float*)kp[33];
  q.ws = (char*)(__attribute__((address_space(1))) char*)kp[34];
  return q;
}

#define XB_TMO      128
#define XB_XCNT(j)  (256  + 64 * (j))
#define XB_XSUB(j)  (1280 + 64 * (j))
#define XB_XGEN(j)  (2304 + 64 * (j))
#define XB_TOP      3328
#define XB_TOPGEN   3392
#define XCD_BAR_WORDS 3456
#define XB_SPIN_CAP (1u << 18)
#define LAS __attribute__((address_space(3)))
DI unsigned xb_ld(unsigned* p)              { return __hip_atomic_load(p, __ATOMIC_RELAXED, __HIP_MEMORY_SCOPE_AGENT); }
DI unsigned xb_add(unsigned* p, unsigned v) { return __hip_atomic_fetch_add(p, v, __ATOMIC_RELAXED, __HIP_MEMORY_SCOPE_AGENT); }
DI unsigned xb_xcc_id() { return (unsigned)__builtin_amdgcn_s_getreg((3 << 11) | 20) & 0xFu; }
#define XB_SPIN(cond, bar) do { unsigned _sp = 0; while (cond) { __builtin_amdgcn_s_sleep(1); \
    if ((++_sp & 255u) == 0u) { if (xb_ld(&(bar)[XB_TMO])) break; if (_sp > XB_SPIN_CAP) { atomicAdd(&(bar)[XB_TMO], 1u); break; } } } } while (0)
struct XcdBarrier { unsigned* bar; unsigned x; volatile LAS unsigned* st; };
DI XcdBarrier xcd_barrier_post(unsigned* bar, volatile LAS unsigned* st) {
  XcdBarrier b; b.bar = bar; b.x = xb_xcc_id(); b.st = st;
  if (threadIdx.x == 0) (void)xb_add(&bar[XB_XCNT(b.x)], 1u);
  return b;
}
DI void xcd_barrier_complete(unsigned* bar, unsigned x, unsigned& nloc, unsigned& nx) {
  const unsigned G = gridDim.x * gridDim.y * gridDim.z;
  unsigned sum, cnt, mine, sp = 0u;
  for (;;) {
    sum = 0u; cnt = 0u; mine = 0u;
#pragma unroll
    for (unsigned j = 0; j < 16; ++j) { const unsigned c = xb_ld(&bar[XB_XCNT(j)]); sum += c; cnt += (c > 0u) ? 1u : 0u; mine = (j == x) ? c : mine; }
    if (sum == G) break;
    __builtin_amdgcn_s_sleep(1);
    if ((++sp & 255u) == 0u) { if (xb_ld(&bar[XB_TMO])) break; if (sp > XB_SPIN_CAP) { atomicAdd(&bar[XB_TMO], 1u); break; } }
  }
  nloc = mine > 0u ? mine : 1u; nx = cnt > 0u ? cnt : 1u;
}
DI void xcd_barrier(const XcdBarrier& b) {
  asm volatile("s_waitcnt vmcnt(0)" ::: "memory");
  __syncthreads();
  if (threadIdx.x == 0) {
    unsigned* bar = b.bar;
    __builtin_amdgcn_s_waitcnt(0);
    unsigned nloc = b.st[0], nx = b.st[1];
    if (nloc == 0u) { xcd_barrier_complete(bar, b.x, nloc, nx); b.st[0] = nloc; b.st[1] = nx; }
    const unsigned old = xb_add(&bar[XB_XSUB(b.x)], 1u);
    const unsigned gen = old / nloc;
    if (old + 1u == (gen + 1u) * nloc) {
      __builtin_amdgcn_fence(__ATOMIC_RELEASE, "agent");
      asm volatile("s_waitcnt vmcnt(0)" ::: "memory");
      const unsigned og = xb_add(&bar[XB_TOP], 1u);
      const unsigned tg = og / nx;
      if (og + 1u == (tg + 1u) * nx) xb_add(&bar[XB_TOPGEN], 1u);
      else XB_SPIN(xb_ld(&bar[XB_TOPGEN]) == tg, bar);
      __builtin_amdgcn_fence(__ATOMIC_ACQUIRE, "agent");
      xb_add(&bar[XB_XGEN(b.x)], 1u);
      asm volatile("s_waitcnt vmcnt(0)" ::: "memory");
    } else {
      XB_SPIN(xb_ld(&bar[XB_XGEN(b.x)]) == gen, bar);
      __builtin_amdgcn_fence(__ATOMIC_ACQUIRE, "agent");
      asm volatile("s_waitcnt vmcnt(0)" ::: "memory");
    }
  }
  __syncthreads();
}

#ifndef ONLY_PH
#define ONLY_PH -1
#endif
#ifndef SKIP_PH
#define SKIP_PH -2
#endif
#ifndef SKIP_PH2
#define SKIP_PH2 -2
#endif
#ifndef PROBE
#define PROBE 0
#endif
#define PH(n) ((ONLY_PH < 0 || ONLY_PH == (n)) && SKIP_PH != (n) && SKIP_PH2 != (n))
__global__ void __launch_bounds__(NTHREADS, LB2) mega(Params p) {
  __shared__ __attribute__((aligned(16))) char smem[SMEM_BYTES];
  cg::grid_group grid = cg::this_grid();
  __shared__ uint4 xb_words;
  if (threadIdx.x == 0) xb_words = make_uint4(0u, 0u, 0u, 0u);
  __syncthreads();
  const XcdBarrier xb = xcd_barrier_post((unsigned*)(p.ws + OFF_BAR), (volatile LAS unsigned*)&xb_words);
  if (PH(0)) { const Params q = ldp(); const u16* W = (const u16*)(q.ws + OFF_W); (void)W; phase_prologue(q, smem); }
  if (p.out == nullptr) grid.sync();
  xcd_barrier(xb);
  if (PH(1)) { const Params q = ldp(); const u16* W = (const u16*)(q.ws + OFF_W); (void)W; phase_norm(q, 0, MALL); }
  xcd_barrier(xb);
  if (PROBE & 32) { const Params q = ldp(); phase_sgu_g1_dry(q, MALL, smem); xcd_barrier(xb); }
  if (PH(2)) { const Params q = ldp(); const u16* W = (const u16*)(q.ws + OFF_W); (void)W; phase_sgu_g1(q, 0, MALL, smem); }
  xcd_barrier(xb);
  if (PH(3)) { const Params q = ldp(); const u16* W = (const u16*)(q.ws + OFF_W); (void)W; phase_sgu_mix(q, 0, MALL, smem); }
  xcd_barrier(xb);
  if (PH(4)) { const Params q = ldp(); const u16* W = (const u16*)(q.ws + OFF_W); (void)W; phase_outproj(q, 0, (const u16*)(q.ws + OFF_GUZ), 2048, W + W_SGUOUT, MALL, smem); }
  xcd_barrier(xb);
  if (PH(5)) { const Params q = ldp(); const u16* W = (const u16*)(q.ws + OFF_W); (void)W; phase_norm(q, 1, MALL); }
  xcd_barrier(xb);
  if (PROBE & 4) { const Params q = ldp(); phase_rwkv_g(q, smem); xcd_barrier(xb); }
  if (PH(6)) { const Params q = ldp(); const u16* W = (const u16*)(q.ws + OFF_W); (void)W; phase_rwkv_g(q, smem); }
  xcd_barrier(xb);
  if (PROBE & 2) { const Params q = ldp(); phase_scan_seq(q, smem); xcd_barrier(xb); }
  if (PH(7)) { const Params q = ldp(); phase_scan_seq(q, smem); }
  xcd_barrier(xb);
  if (PH(10)) { const Params q = ldp(); const u16* W = (const u16*)(q.ws + OFF_W); (void)W; phase_rwkv_ln(q); }
  xcd_barrier(xb);
  if (PH(11)) { const Params q = ldp(); const u16* W = (const u16*)(q.ws + OFF_W); (void)W; phase_outproj(q, 1, (const u16*)(q.ws + OFF_Z), 1024, W + W_ROUT, MALL, smem); }
  xcd_barrier(xb);
  if (PH(12)) { const Params q = ldp(); const u16* W = (const u16*)(q.ws + OFF_W); (void)W; phase_norm(q, 2, MALL); }
  xcd_barrier(xb);
  if (PH(13)) { const Params q = ldp(); const u16* W = (const u16*)(q.ws + OFF_W); (void)W; phase_mla_in(q, smem); }
  xcd_barrier(xb);
#pragma unroll 1
  for (int g = 0; g < 4; ++g) {
    if (PROBE & 8) { const Params q = ldp(); phase_mla_up(q, g, smem); xcd_barrier(xb); }
    if (PH(14)) { const Params q = ldp(); const u16* W = (const u16*)(q.ws + OFF_W); (void)W; phase_mla_up(q, g, smem); }
    xcd_barrier(xb);
    if (PROBE & 1) { const Params q = ldp(); phase_attn(q, g, smem, true); xcd_barrier(xb); }
    if (PH(15)) { const Params q = ldp(); const u16* W = (const u16*)(q.ws + OFF_W); (void)W; phase_attn(q, g, smem); }
    xcd_barrier(xb);
  }
  if (PH(22)) { const Params q = ldp(); const u16* W = (const u16*)(q.ws + OFF_W); (void)W; phase_outproj(q, 2, (const u16*)(q.ws + OFF_SZ), 2048, W + W_MOUT, T, smem); }
  xcd_barrier(xb);
  if (PH(23)) { const Params q = ldp(); const u16* W = (const u16*)(q.ws + OFF_W); (void)W; phase_norm(q, 3, T); }
  xcd_barrier(xb);
  if (PH(24)) { const Params q = ldp(); const u16* W = (const u16*)(q.ws + OFF_W); (void)W; phase_sgu_g1(q, 3, T, smem); }
  xcd_barrier(xb);
  if (PH(25)) { const Params q = ldp(); const u16* W = (const u16*)(q.ws + OFF_W); (void)W; phase_sgu_mix(q, 3, T, smem); }
  xcd_barrier(xb);
  if (PH(26)) { const Params q = ldp(); const u16* W = (const u16*)(q.ws + OFF_W); (void)W; phase_outproj(q, 3, (const u16*)(q.ws + OFF_GUZ), 2048, W + W_SGUOUT + 1024ull * 2048, T, smem); }
}

extern "C" void kernel_launch(void* const* d_in, const int* in_sizes, int n_in, void* d_out, int out_size, void* d_ws, size_t ws_size, hipStream_t stream) {
  static int grid_blocks = 0;
  if (!grid_blocks) {
    int dev = 0, cus = 0, per_cu = 0;
    hipGetDevice(&dev);
    hipDeviceGetAttribute(&cus, hipDeviceAttributeMultiprocessorCount, dev);
    hipOccupancyMaxActiveBlocksPerMultiprocessor(&per_cu, mega, NTHREADS, 0);
    if (per_cu > 2) per_cu = 2;
    if (per_cu < 1) per_cu = 1;
    grid_blocks = cus * per_cu;
  }
  Params p{};
  const float** f = (const float**)&p;
  for (int i = 0; i < 33; ++i) f[i] = (const float*)d_in[i];
  p.out = (float*)d_out;
  p.ws = (char*)d_ws;
  hipMemsetAsync((char*)d_ws + OFF_BAR, 0, XCD_BAR_WORDS * 4, stream);
  void* args[] = {&p};
  hipError_t e = hipLaunchCooperativeKernel((void*)mega, dim3(grid_blocks), dim3(NTHREADS), args, 0, stream);
  if (e != hipSuccess) fprintf(stderr, "cooperative launch failed: %s (grid %d)\n", hipGetErrorString(e), grid_blocks);
}
```

```cpp
#include <hip/hip_runtime.h>
#include <hip/hip_cooperative_groups.h>
#include <cstdio>
#include <cstdint>
namespace cg = cooperative_groups;

#define DI __device__ __forceinline__
typedef unsigned short u16;
typedef short bf16x8 __attribute__((ext_vector_type(8)));
typedef float f32x16 __attribute__((ext_vector_type(16)));
typedef float f32x4 __attribute__((ext_vector_type(4)));
typedef float f32x2 __attribute__((ext_vector_type(2)));
typedef unsigned u32x4 __attribute__((ext_vector_type(4)));
typedef unsigned u32x2 __attribute__((ext_vector_type(2)));
typedef _Float16 h16;
typedef _Float16 h16x8 __attribute__((ext_vector_type(8)));
typedef _Float16 h16x4 __attribute__((ext_vector_type(4)));

constexpr int D = 1024, NB = 8, SEQ = 8192, CTXL = 256;
constexpr int T = NB * SEQ;
constexpr int TC = NB * CTXL;
constexpr int MALL = T + TC;
constexpr int SMEM_BYTES = 73728;
constexpr int NTHREADS = 256;
#ifndef LB2
#define LB2 2
#endif

constexpr size_t MB = 1ull << 20;
constexpr size_t OFF_W = 0;
constexpr size_t W_SGUIN = 0;
constexpr size_t W_SGUOUT = W_SGUIN + 2ull * 6144 * 1024;
constexpr size_t W_RIN = W_SGUOUT + 2ull * 1024 * 2048;
constexpr size_t W_L1W = W_RIN + 4ull * 1024 * 1024;
constexpr size_t W_L1A = W_L1W + 128ull * 1024;
constexpr size_t W_ROUT = W_L1A + 128ull * 1024;
constexpr size_t W_MIN = W_ROUT + 1024ull * 1024;
constexpr size_t W_UQ = W_MIN + 3200ull * 1024;
constexpr size_t W_UKV = W_UQ + 3072ull * 768;
constexpr size_t W_MOUT = W_UKV + 4096ull * 256;
constexpr size_t W_L2W = W_MOUT + 1024ull * 2048;
constexpr size_t W_L2A = W_L2W + 2ull * 1024 * 64;
constexpr size_t W_END = W_L2A + 2ull * 1024 * 64;
static_assert(W_END * 2 <= 64 * MB, "weights region");
constexpr size_t OFF_MOD = 64 * MB;
constexpr size_t OFF_CS = OFF_MOD + 512 * 1024;
constexpr size_t OFF_MU16 = OFF_CS + 32 * 1024;
constexpr size_t OFF_BAR = OFF_CS + 48 * 1024;
constexpr size_t OFF_SSQA = OFF_CS + 64 * 1024;
constexpr size_t OFF_SSQB = OFF_SSQA + 512 * 1024;
constexpr size_t OFF_SSQR = OFF_SSQB + 512 * 1024;
constexpr size_t OFF_CTX = 66 * MB;
constexpr size_t OFF_BIG = 76 * MB;
constexpr size_t SZ_ACT = (size_t)MALL * 1024 * 2;
constexpr size_t OFF_H = OFF_BIG;
constexpr size_t OFF_GUZ = OFF_H + SZ_ACT;
constexpr size_t OFF_GVT = OFF_GUZ + 2 * SZ_ACT;
constexpr size_t OFF_R = OFF_H + SZ_ACT;
constexpr size_t OFF_K = OFF_R + SZ_ACT;
constexpr size_t OFF_V = OFF_K + SZ_ACT;
constexpr size_t OFF_Z = OFF_V + SZ_ACT;
constexpr size_t OFF_TW = OFF_Z + SZ_ACT;
constexpr size_t OFF_TA = OFF_TW + (size_t)MALL * 128 * 2;
constexpr size_t OFF_BS = OFF_TA + (size_t)MALL * 128 * 2;
constexpr size_t OFF_SUMM = OFF_BS + (size_t)MALL * 32 * 4;
constexpr size_t OFF_Y1 = OFF_SUMM;
constexpr int NUNIT = NB * 16 * 33;
constexpr size_t RWKV_END = OFF_SUMM + (size_t)NUNIT * 4 * 4096 * 2;
constexpr size_t OFF_CQ = OFF_H + SZ_ACT;
constexpr size_t OFF_CKV = OFF_CQ + (size_t)T * 768 * 2;
constexpr size_t OFF_KR = OFF_CKV + (size_t)MALL * 256 * 2;
constexpr size_t OFF_SZ = OFF_KR + (size_t)MALL * 64 * 4;
constexpr size_t OFF_QX = OFF_SZ + (size_t)T * 2048 * 2;
constexpr size_t OFF_KX = OFF_QX + 16384ull * 16 * 256 * 2;
constexpr size_t OFF_VT = OFF_KX + 2ull * 8448 * 16 * 192 * 2;
constexpr size_t MLA_END = OFF_VT + 2ull * 16 * 128 * 8448 * 2;
constexpr size_t WS_NEED = (RWKV_END > MLA_END ? RWKV_END : MLA_END);
static_assert(WS_NEED <= 1024 * MB, "workspace");
static_assert(OFF_GVT + 2 * SZ_ACT <= 1024 * MB, "workspace sgu");

struct Params {
  const float *x, *c, *ctx, *c_ctx, *ada_w, *ada_b;
  const float *sgu_w_in, *sgu_gain, *sgu_w_s, *sgu_b_s, *sgu_w_out;
  const float *rwkv_mu, *rwkv_w_in, *rwkv_w_lora1, *rwkv_w_lora2, *rwkv_w0, *rwkv_a_lora1, *rwkv_a_lora2, *rwkv_a0;
  const float *rwkv_k_k, *rwkv_k_a, *rwkv_r_k, *rwkv_ln_gain, *rwkv_ln_bias, *rwkv_w_out;
  const float *mla_w_in, *mla_q_norm, *mla_kv_norm, *mla_w_uq, *mla_w_ukv, *mla_qk_gain_q, *mla_qk_gain_k, *mla_w_out;
  float* out;
  char* ws;
};

DI u16 f2bf(float x) { unsigned u = __float_as_uint(x); u += 0x7fffu + ((u >> 16) & 1u); return (u16)(u >> 16); }
typedef __bf16 bf16x2_t __attribute__((ext_vector_type(2)));
DI unsigned pack2bf(float a, float b) { const f32x2 v = (f32x2){a, b}; return __builtin_bit_cast(unsigned, __builtin_convertvector(v, bf16x2_t)); }
DI float bflo(unsigned v) { return __uint_as_float(v << 16); }
DI float bfhi(unsigned v) { return __uint_as_float(v & 0xffff0000u); }
DI float sigmoidf_(float x) { return __builtin_amdgcn_rcpf(1.0f + __builtin_amdgcn_exp2f(-1.4426950408889634f * x)); }
DI float siluf_(float x) { return x * sigmoidf_(x); }
DI float geluf_(float x) { const float u = 0.7978845608028654f * (x + 0.044715f * x * x * x); return x * sigmoidf_(2.0f * u); }
DI int crow(int i, int h) { return (i & 3) + 8 * (i >> 2) + 4 * h; }
DI float wave_sum(float v) {
#pragma unroll
  for (int o = 32; o >= 1; o >>= 1) v += __shfl_xor(v, o);
  return v;
}
#define MFMA(a, b, c) __builtin_amdgcn_mfma_f32_32x32x16_bf16((a), (b), (c), 0, 0, 0)

DI int mod_row(int row) { return row < T ? (row >> 13) : 8; }

constexpr int LROW = 144;
template <int MI, int NI, bool F16 = false, class XL, class EPI>
DI void gemm_tile(const XL& xl, const u16* __restrict__ Wt, int ldw, int K, const EPI& epi, char* smem) {
  constexpr int BN = NI * 32, BM = MI * 128;
  constexpr int WCH = BN * 8 / NTHREADS, XCH = BM * 8 / NTHREADS;
  int tid_ = threadIdx.x; asm volatile("" : "+v"(tid_));
  const int tid = tid_, lane = tid & 63, w = tid >> 6, r = lane & 31, h = lane >> 5;
  char* Xs = smem;
  char* Ws = smem + BM * LROW;
  u32x4 xr[XCH], wr[WCH];
  f32x16 acc[MI][NI];
#pragma unroll
  for (int mi = 0; mi < MI; ++mi)
#pragma unroll
    for (int ni = 0; ni < NI; ++ni)
#pragma unroll
      for (int i = 0; i < 16; ++i) acc[mi][ni][i] = 0.f;
#pragma unroll
  for (int j = 0; j < XCH; ++j) { const int c = tid + NTHREADS * j; xr[j] = xl(c >> 3, (c & 7) * 8); }
#pragma unroll
  for (int j = 0; j < WCH; ++j) { const int c = tid + NTHREADS * j; wr[j] = *(const u32x4*)(Wt + (unsigned)((c >> 3) * ldw + (c & 7) * 8)); }
  for (int k0 = 0; k0 < K; k0 += 64) {
    __syncthreads();
#pragma unroll
    for (int j = 0; j < XCH; ++j) { const int c = tid + NTHREADS * j; *(u32x4*)(Xs + (c >> 3) * LROW + (c & 7) * 16) = xr[j]; }
#pragma unroll
    for (int j = 0; j < WCH; ++j) { const int c = tid + NTHREADS * j; *(u32x4*)(Ws + (c >> 3) * LROW + (c & 7) * 16) = wr[j]; }
    if (k0 + 64 < K) {
#pragma unroll
      for (int j = 0; j < XCH; ++j) { const int c = tid + NTHREADS * j; xr[j] = xl(c >> 3, k0 + 64 + (c & 7) * 8); }
#pragma unroll
      for (int j = 0; j < WCH; ++j) { const int c = tid + NTHREADS * j; wr[j] = *(const u32x4*)(Wt + (unsigned)((c >> 3) * ldw + k0 + 64 + (c & 7) * 8)); }
    }
    __syncthreads();
#pragma unroll
    for (int s = 0; s < 4; ++s) {
      bf16x8 xf[MI];
#pragma unroll
      for (int mi = 0; mi < MI; ++mi) xf[mi] = *(const bf16x8*)(Xs + (32 * (MI * w + mi) + r) * LROW + (16 * s + 8 * h) * 2);
#pragma unroll
      for (int ni = 0; ni < NI; ++ni) {
        const bf16x8 wf = *(const bf16x8*)(Ws + (32 * ni + r) * LROW + (16 * s + 8 * h) * 2);
#pragma unroll
        for (int mi = 0; mi < MI; ++mi) {
          if (F16) acc[mi][ni] = __builtin_amdgcn_mfma_f32_32x32x16_f16(__builtin_bit_cast(h16x8, wf), __builtin_bit_cast(h16x8, xf[mi]), acc[mi][ni], 0, 0, 0);
          else acc[mi][ni] = MFMA(wf, xf[mi], acc[mi][ni]);
        }
        if (NI == 8 && (ni & 3) == 3) __builtin_amdgcn_sched_barrier(0);
      }
    }
  }
#pragma unroll
  for (int mi = 0; mi < MI; ++mi) epi(acc[mi], MI * w + mi, r, h);
}


typedef __attribute__((address_space(3))) void* lds_ptr_t;
typedef const __attribute__((address_space(1))) void* glb_ptr_t;
constexpr int GL_STAGE = 24576;
template <class EPI>
DI void gemm_tile_glds(const u16* __restrict__ X, int ldx, const u16* __restrict__ Wt, int ldw, int K, const EPI& epi, char* smem) {
  int tid_ = threadIdx.x; asm volatile("" : "+v"(tid_));
  const int tid = tid_, lane = tid & 63, w = tid >> 6, r = lane & 31, h = lane >> 5;
  const int cs = (tid & 3) ^ ((tid >> 4) & 3);
  const u16* gx = X + (unsigned)((tid >> 2) * ldx + cs * 8);
  const u16* gw = Wt + (unsigned)((tid >> 2) * ldw + cs * 8);
  char* ldst = smem + tid * 16;
  f32x16 acc[2][4];
#pragma unroll
  for (int mi = 0; mi < 2; ++mi)
#pragma unroll
    for (int ni = 0; ni < 4; ++ni)
#pragma unroll
      for (int i = 0; i < 16; ++i) acc[mi][ni][i] = 0.f;
  const int NK = K >> 5;
  auto issue = [&](int kt) {
    char* d = ldst + (kt % 3) * GL_STAGE;
    const u16* sx = gx + kt * 32; const u16* sw = gw + kt * 32;
#pragma unroll
    for (int i = 0; i < 4; ++i) __builtin_amdgcn_global_load_lds((glb_ptr_t)(sx + (unsigned)(i * 64 * ldx)), (lds_ptr_t)(d + i * 4096), 16, 0, 0);
#pragma unroll
    for (int i = 0; i < 2; ++i) __builtin_amdgcn_global_load_lds((glb_ptr_t)(sw + (unsigned)(i * 64 * ldw)), (lds_ptr_t)(d + 16384 + i * 4096), 16, 0, 0);
  };
  asm volatile("s_waitcnt vmcnt(0)" ::: "memory");
  __builtin_amdgcn_s_barrier();
  asm volatile("" ::: "memory");
  issue(0); issue(1);
  const int swz = (r >> 2) & 3;
  int xo2[2], wo2[2];
#pragma unroll
  for (int s2 = 0; s2 < 2; ++s2) { const int cofs = ((2 * s2 + h) ^ swz) << 4; xo2[s2] = (64 * w + r) * 64 + cofs; wo2[s2] = 16384 + r * 64 + cofs; }
#pragma unroll 1
  for (int kt = 0; kt < NK; ++kt) {
    if (kt + 1 < NK) asm volatile("s_waitcnt vmcnt(6)" ::: "memory"); else asm volatile("s_waitcnt vmcnt(0)" ::: "memory");
    __builtin_amdgcn_s_barrier();
    asm volatile("" ::: "memory");
    if (kt + 2 < NK) issue(kt + 2);
    const char* sb = smem + (kt % 3) * GL_STAGE;
#pragma unroll
    for (int s2 = 0; s2 < 2; ++s2) {
      bf16x8 xf[2];
#pragma unroll
      for (int mi = 0; mi < 2; ++mi) xf[mi] = *(const bf16x8*)(sb + xo2[s2] + mi * 2048);
#pragma unroll
      for (int ni = 0; ni < 4; ++ni) {
        const bf16x8 wf = *(const bf16x8*)(sb + wo2[s2] + ni * 2048);
#pragma unroll
        for (int mi = 0; mi < 2; ++mi) acc[mi][ni] = MFMA(wf, xf[mi], acc[mi][ni]);
      }
    }
    asm volatile("" ::: "memory");
  }
#pragma unroll
  for (int mi = 0; mi < 2; ++mi) epi(acc[mi], 2 * w + mi, r, h);
}

struct XPlain {
  const u16* base; int ld;
  DI u32x4 operator()(int row, int k) const { return *(const u32x4*)(base + (unsigned)(row * ld + k)); }
};

struct Job { const float* src; u16* dst; int K, Nsrc, Ndst, map; const float* scale; int f16; };
constexpr int NJOBS = 21;
DI Job get_job(const Params& p, int j) {
  u16* W = (u16*)(p.ws + OFF_W);
  Job jb; jb.scale = nullptr; jb.map = 0; jb.f16 = 0;
  if (j < 2) { jb.src = p.sgu_w_in + (size_t)j * 1024 * 6144; jb.dst = W + W_SGUIN + (size_t)j * 6144 * 1024; jb.K = 1024; jb.Nsrc = 6144; jb.Ndst = 6144; jb.map = 1; }
  else if (j < 4) { jb.src = p.sgu_w_out + (size_t)(j - 2) * 2048 * 1024; jb.dst = W + W_SGUOUT + (size_t)(j - 2) * 1024 * 2048; jb.K = 2048; jb.Nsrc = 1024; jb.Ndst = 1024; }
  else if (j < 8) { jb.src = p.rwkv_w_in + (size_t)(j - 4) * 1024 * 1024; jb.dst = W + W_RIN + (size_t)(j - 4) * 1024 * 1024; jb.K = 1024; jb.Nsrc = 1024; jb.Ndst = 1024; }
  else if (j < 10) { jb.src = p.rwkv_w_lora1 + (size_t)(j - 8) * 1024 * 64; jb.dst = W + W_L1W + (size_t)(j - 8) * 64 * 1024; jb.K = 1024; jb.Nsrc = 64; jb.Ndst = 64; }
  else if (j < 12) { jb.src = p.rwkv_a_lora1 + (size_t)(j - 10) * 1024 * 64; jb.dst = W + W_L1A + (size_t)(j - 10) * 64 * 1024; jb.K = 1024; jb.Nsrc = 64; jb.Ndst = 64; }
  else if (j == 12) { jb.src = p.rwkv_w_out; jb.dst = W + W_ROUT; jb.K = 1024; jb.Nsrc = 1024; jb.Ndst = 1024; }
  else if (j == 13) { jb.src = p.mla_w_in; jb.dst = W + W_MIN; jb.K = 1024; jb.Nsrc = 3136; jb.Ndst = 3200; jb.map = 2; }
  else if (j == 14) { jb.src = p.mla_w_uq; jb.dst = W + W_UQ; jb.K = 768; jb.Nsrc = 3072; jb.Ndst = 3072; jb.scale = p.mla_q_norm; }
  else if (j == 15) { jb.src = p.mla_w_ukv; jb.dst = W + W_UKV; jb.K = 256; jb.Nsrc = 4096; jb.Ndst = 4096; jb.scale = p.mla_kv_norm; }
  else if (j == 16) { jb.src = p.mla_w_out; jb.dst = W + W_MOUT; jb.K = 2048; jb.Nsrc = 1024; jb.Ndst = 1024; }
  else if (j < 19) { jb.src = p.rwkv_w_lora2 + (size_t)(j - 17) * 64 * 1024; jb.dst = W + W_L2W + (size_t)(j - 17) * 1024 * 64; jb.K = 64; jb.Nsrc = 1024; jb.Ndst = 1024; jb.f16 = 1; }
  else { jb.src = p.rwkv_a_lora2 + (size_t)(j - 19) * 64 * 1024; jb.dst = W + W_L2A + (size_t)(j - 19) * 1024 * 64; jb.K = 64; jb.Nsrc = 1024; jb.Ndst = 1024; jb.f16 = 1; }
  return jb;
}
DI int map_col(int map, int n) {
  if (map == 0) return n;
  if (map == 1) {
    if (n >= 4096) return 2048 + (n - 4096);
    const int nt = n >> 7, j = n & 127, pp = j >> 6, ns = (j >> 5) & 1, cc = j & 31;
    const int ch = nt * 64 + pp * 32 + cc;
    return ns ? 4096 + ch : ch;
  }
  if (n < 1024) return n;
  if (n < 3072) return n + 64;
  if (n < 3136) return n - 2048;
  return -1;
}

DI void phase_prologue(const Params& p, char* smem) {
  const int tid = threadIdx.x;
  for (int item = blockIdx.x; ; item += gridDim.x) {
    if (item < 48) {
      float* cs = (float*)smem;
      for (int i = tid; i < 9 * 1024; i += NTHREADS) { const float v = i < 8192 ? p.c[i] : p.c_ctx[i - 8192]; cs[i] = siluf_(v); }
      __syncthreads();
      const int gi = item * 256 + tid; const int l = gi / 3072, n = gi % 3072;
      const float* wp = p.ada_w + (size_t)l * 1024 * 3072 + n;
      float a[9];
#pragma unroll
      for (int m = 0; m < 9; ++m) a[m] = p.ada_b[l * 3072 + n];
#pragma unroll 32
      for (int k = 0; k < 1024; ++k) { const float wv = wp[(size_t)k * 3072];
#pragma unroll
        for (int m = 0; m < 9; ++m) a[m] += cs[m * 1024 + k] * wv; }
      float* mo = (float*)(p.ws + OFF_MOD);
#pragma unroll
      for (int m = 0; m < 9; ++m) mo[((size_t)l * 9 + m) * 3072 + n] = a[m];
      __syncthreads();
      continue;
    }
    if (item == 48) {
      f32x2* cs = (f32x2*)(p.ws + OFF_CS);
      for (int i = tid; i < 3072; i += NTHREADS) {
        const int pos = i < 2048 ? (i >> 4) : ((i - 2048) >> 4); const int f = i & 15;
        const float invf = exp2f(-(float)f * (13.287712379549449f / 16.0f));
        const float ang = (float)pos * invf; float s, c; sincosf(ang, &s, &c);
        cs[i] = (f32x2){c, s};
      }
      h16* mu16 = (h16*)(p.ws + OFF_MU16);
      for (int i = tid; i < 6 * 1024; i += NTHREADS) mu16[i] = (h16)p.rwkv_mu[i];
      continue;
    }
    int ti = item - 49; int j = 0; Job jb;
    for (; j < NJOBS; ++j) { jb = get_job(p, j); const int nt = (jb.Ndst / 64) * (jb.K / 64); if (ti < nt) break; ti -= nt; }
    if (j >= NJOBS) break;
    const int nkt = jb.K / 64; const int nt = ti / nkt, kt = ti % nkt;
    float* tile = (float*)smem;
#pragma unroll 4
    for (int q = 0; q < 16; ++q) {
      const int kk = (tid >> 6) + 4 * q, nn = tid & 63; const int sc = map_col(jb.map, nt * 64 + nn); const int k = kt * 64 + kk;
      float v = 0.f; if (sc >= 0) { v = jb.src[(size_t)k * jb.Nsrc + sc]; if (jb.scale) v *= jb.scale[k]; }
      tile[nn * 65 + kk] = v;
    }
    __syncthreads();
    { const int nn = tid >> 2, kq = tid & 3; unsigned o[8];
#pragma unroll
      for (int q = 0; q < 8; ++q) { const float a = tile[nn * 65 + kq * 16 + 2 * q], b = tile[nn * 65 + kq * 16 + 2 * q + 1];
        if (jb.f16) { const h16 ha = (h16)a, hb = (h16)b; o[q] = (unsigned)__builtin_bit_cast(u16, ha) | ((unsigned)__builtin_bit_cast(u16, hb) << 16); } else o[q] = pack2bf(a, b); }
      u32x4* dp = (u32x4*)(jb.dst + (size_t)(nt * 64 + nn) * jb.K + kt * 64 + kq * 16);
      dp[0] = (u32x4){o[0], o[1], o[2], o[3]}; dp[1] = (u32x4){o[4], o[5], o[6], o[7]}; }
    __syncthreads();
  }
}

DI void phase_norm(const Params& p, int l, int nrows) {
  const int lane = threadIdx.x & 63, w = threadIdx.x >> 6;
  const float* mo = (const float*)(p.ws + OFF_MOD) + (size_t)l * 9 * 3072;
  u16* H = (u16*)(p.ws + OFF_H);
  float* sa = (float*)(p.ws + OFF_SSQA); float* sb = (float*)(p.ws + OFF_SSQB);
  for (int row = blockIdx.x * 4 + w; row < nrows; row += gridDim.x * 4) {
    const float* xs = row < T ? ((l == 0 ? p.x : p.out) + (size_t)row * D) : ((l == 0 ? p.ctx : (const float*)(p.ws + OFF_CTX)) + (size_t)(row - T) * D);
    f32x4 v[4]; float ss = 0.f;
#pragma unroll
    for (int j = 0; j < 4; ++j) { v[j] = *(const f32x4*)(xs + lane * 4 + 256 * j); ss += v[j][0] * v[j][0] + v[j][1] * v[j][1] + v[j][2] * v[j][2] + v[j][3] * v[j][3]; }
    ss = wave_sum(ss);
    const float rinv = rsqrtf(ss * (1.0f / 1024.0f) + 1e-6f);
    const float* m = mo + (size_t)mod_row(row) * 3072;
#pragma unroll
    for (int j = 0; j < 4; ++j) {
      const int cidx = lane * 4 + 256 * j;
      const f32x4 sh = *(const f32x4*)(m + cidx), sc = *(const f32x4*)(m + 1024 + cidx);
      float o[4];
#pragma unroll
      for (int e = 0; e < 4; ++e) o[e] = v[j][e] * rinv * (1.0f + sc[e]) + sh[e];
      *(u32x2*)(H + (size_t)row * D + cidx) = (u32x2){pack2bf(o[0], o[1]), pack2bf(o[2], o[3])};
    }
    if (lane == 0) { sa[row] = 0.f; sb[row] = 0.f; }
  }
}

DI void stagger(int nsleep) { if (blockIdx.x >= 256) for (int i = 0; i < nsleep; ++i) __builtin_amdgcn_s_sleep(127); }
struct EpiResidual {
  const Params* p; int l, m0, n0;
  DI void operator()(const f32x16 (&acc)[4], int w, int r, int h) const {
    const int row = m0 + 32 * w + r;
    const float* xin; float* xo;
    if (row < T) { xin = (l == 0 ? p->x : p->out) + (size_t)row * D; xo = p->out + (size_t)row * D; }
    else { xin = (l == 0 ? p->ctx : (const float*)(p->ws + OFF_CTX)) + (size_t)(row - T) * D; xo = (float*)(p->ws + OFF_CTX) + (size_t)(row - T) * D; }
    const float* g = (const float*)(p->ws + OFF_MOD) + ((size_t)l * 9 + mod_row(row)) * 3072 + 2048;
#pragma unroll
    for (int hf = 0; hf < 2; ++hf) {
      f32x4 xv[8], gv[8];
#pragma unroll
      for (int j = 0; j < 8; ++j) { const int ni = 2 * hf + (j >> 2), q = j & 3; const int n = n0 + 32 * ni + 8 * q + 4 * h; xv[j] = *(const f32x4*)(xin + n); gv[j] = *(const f32x4*)(g + n); }
#pragma unroll
      for (int j = 0; j < 8; ++j) { const int ni = 2 * hf + (j >> 2), q = j & 3; const int n = n0 + 32 * ni + 8 * q + 4 * h;
        f32x4 o;
#pragma unroll
        for (int e = 0; e < 4; ++e) o[e] = xv[j][e] + gv[j][e] * acc[ni][4 * q + e];
        *(f32x4*)(xo + n) = o; }
    }
  }
};
DI void phase_outproj(const Params& p, int l, const u16* X, int K, const u16* Wt, int nrows, char* smem) {
  const int ntile = (nrows / 256) * 8;
  for (int t = blockIdx.x; t < ntile; t += gridDim.x) {
    const int xcd = t & 7, lg = t >> 3; const int mt = (lg >> 3) * 8 + xcd, nt = lg & 7;
    EpiResidual ep{&p, l, mt * 256, nt * 128};
    gemm_tile_glds(X + (size_t)mt * 256 * K, K, Wt + (size_t)nt * 128 * K, K, K, ep, smem);
  }
}

struct EpiSguUZ {
  u16* guz; int m0, nt;
  DI void operator()(const f32x16 (&acc)[4], int w, int r, int h) const {
    const int row = m0 + 32 * w + r;
#pragma unroll
    for (int pp = 0; pp < 2; ++pp)
#pragma unroll
      for (int q = 0; q < 4; ++q) {
        float o[4];
#pragma unroll
        for (int e = 0; e < 4; ++e) {
          const float u = acc[2 * pp][4 * q + e], z = acc[2 * pp + 1][4 * q + e];
          const float a2 = 1.5957691216057308f * (u + 0.044715f * u * u * u);
          const float e1 = __builtin_amdgcn_exp2f(-1.4426950408889634f * a2), e2 = __builtin_amdgcn_exp2f(-1.4426950408889634f * z);
          const float den = fminf((1.0f + e1) * (1.0f + e2), 3.0e38f);
          o[e] = u * z * __builtin_amdgcn_rcpf(den);
        }
        *(u32x2*)(guz + (size_t)row * 2048 + nt * 64 + 32 * pp + 8 * q + 4 * h) = (u32x2){pack2bf(o[0], o[1]), pack2bf(o[2], o[3])};
      }
  }
};
struct EpiSguV {
  u16* gvt; float* ssq; int m0, c0;
  DI void operator()(const f32x16 (&acc)[4], int w, int r, int h) const {
    const int qrow = 32 * w + r; const int chunk = (m0 + qrow) >> 7; const int qpos = qrow & 127;
    float ss = 0.f;
#pragma unroll
    for (int ni = 0; ni < 4; ++ni)
#pragma unroll
      for (int i = 0; i < 16; ++i) {
        const float g = geluf_(acc[ni][i]); ss += g * g;
        gvt[((size_t)chunk * 2048 + c0 + 32 * ni + crow(i, h)) * 128 + qpos] = f2bf(g);
      }
    ss += __shfl_xor(ss, 32);
    if (h == 0) atomicAdd(ssq + m0 + qrow, ss);
  }
};
DI void phase_sgu_g1(const Params& p, int l, int nrows, char* smem) {
  const u16* H = (const u16*)(p.ws + OFF_H);
  const u16* Wt = (const u16*)(p.ws + OFF_W) + W_SGUIN + (size_t)(l ? 1 : 0) * 6144 * 1024;
  const int ntile = (nrows / 256) * 48;
  for (int t = blockIdx.x; t < ntile; t += gridDim.x) {
    const int mt = t / 48, nt = t % 48;
    const u16* xp = H + (size_t)mt * 256 * D;
    if (nt < 32) { EpiSguUZ ep{(u16*)(p.ws + OFF_GUZ), mt * 256, nt}; gemm_tile_glds(xp, D, Wt + (size_t)nt * 128 * D, D, D, ep, smem); }
    else { EpiSguV ep{(u16*)(p.ws + OFF_GVT), (float*)(p.ws + OFF_SSQA), mt * 256, (nt - 32) * 128}; gemm_tile_glds(xp, D, Wt + (size_t)nt * 128 * D, D, D, ep, smem); }
  }
}
struct EpiNull {
  float* sink;
  DI void operator()(const f32x16 (&acc)[4], int w, int r, int h) const {
    float t = 0.f;
#pragma unroll
    for (int ni = 0; ni < 4; ++ni)
#pragma unroll
      for (int i = 0; i < 16; ++i) t += acc[ni][i];
    if (t == 1.2345e38f) sink[threadIdx.x] = t;
  }
};
DI void phase_sgu_g1_dry(const Params& p, int nrows, char* smem) {
  const u16* H = (const u16*)(p.ws + OFF_H);
  const u16* Wt = (const u16*)(p.ws + OFF_W) + W_SGUIN;
  const int ntile = (nrows / 256) * 48;
  for (int t = blockIdx.x; t < ntile; t += gridDim.x) {
    const int mt = t / 48, nt = t % 48;
    EpiNull ep{(float*)(p.ws + OFF_SSQR)};
    gemm_tile_glds(H + (size_t)mt * 256 * D, D, Wt + (size_t)nt * 128 * D, D, D, ep, smem);
  }
}
struct XSguMix {
  const float* ws_g; const float* rinv;
  DI u32x4 operator()(int row, int k) const {
    const f32x4 a = *(const f32x4*)(ws_g + row * 128 + k), b = *(const f32x4*)(ws_g + row * 128 + k + 4);
    const f32x4 ra = *(const f32x4*)(rinv + k), rb = *(const f32x4*)(rinv + k + 4);
    return (u32x4){pack2bf(a[0] * ra[0], a[1] * ra[1]), pack2bf(a[2] * ra[2], a[3] * ra[3]), pack2bf(b[0] * rb[0], b[1] * rb[1]), pack2bf(b[2] * rb[2], b[3] * rb[3])};
  }
};
struct EpiSguMix {
  u16* guz; const float* gain; const float* bs_g; int m0, c0;
  DI void operator()(const f32x16 (&acc)[4], int w, int r, int h) const {
    const int pp = 32 * w + r; const float bias = bs_g[pp];
    u16* rowp = guz + (size_t)(m0 + pp) * 2048 + c0;
    u32x2 gz[16];
#pragma unroll
    for (int j = 0; j < 16; ++j) gz[j] = *(const u32x2*)(rowp + 32 * (j >> 2) + 8 * (j & 3) + 4 * h);
#pragma unroll
    for (int j = 0; j < 16; ++j) {
      const int ni = j >> 2, q = j & 3; const int n = 32 * ni + 8 * q + 4 * h;
      const f32x4 gn = *(const f32x4*)(gain + c0 + n);
      const float o0 = (acc[ni][4 * q] * gn[0] + bias) * bflo(gz[j][0]), o1 = (acc[ni][4 * q + 1] * gn[1] + bias) * bfhi(gz[j][0]);
      const float o2 = (acc[ni][4 * q + 2] * gn[2] + bias) * bflo(gz[j][1]), o3 = (acc[ni][4 * q + 3] * gn[3] + bias) * bfhi(gz[j][1]);
      *(u32x2*)(rowp + n) = (u32x2){pack2bf(o0, o1), pack2bf(o2, o3)};
    }
  }
};
struct EpiSguMix8 {
  u16* guz; const float* gain; const float* bs_g; int m0, c0;
  DI void operator()(const f32x16 (&acc)[8], int w, int r, int h) const {
    const int pp = 32 * w + r; const float bias = bs_g[pp];
    u16* rowp = guz + (size_t)(m0 + pp) * 2048 + c0;
#pragma unroll
    for (int hf = 0; hf < 2; ++hf) {
      u32x2 gz[16];
#pragma unroll
      for (int j = 0; j < 16; ++j) gz[j] = *(const u32x2*)(rowp + 128 * hf + 32 * (j >> 2) + 8 * (j & 3) + 4 * h);
#pragma unroll
      for (int j = 0; j < 16; ++j) {
        const int ni = 4 * hf + (j >> 2), q = j & 3; const int n = 32 * ni + 8 * q + 4 * h;
        const f32x4 gn = *(const f32x4*)(gain + c0 + n);
        const float o0 = (acc[ni][4 * q] * gn[0] + bias) * bflo(gz[j][0]), o1 = (acc[ni][4 * q + 1] * gn[1] + bias) * bfhi(gz[j][0]);
        const float o2 = (acc[ni][4 * q + 2] * gn[2] + bias) * bflo(gz[j][1]), o3 = (acc[ni][4 * q + 3] * gn[3] + bias) * bfhi(gz[j][1]);
        *(u32x2*)(rowp + n) = (u32x2){pack2bf(o0, o1), pack2bf(o2, o3)};
      }
    }
  }
};
DI void phase_sgu_mix(const Params& p, int l, int nrows, char* smem) {
  const int lj = l ? 1 : 0;
  const float* ssq = (const float*)(p.ws + OFF_SSQA);
  float* rinv = (float*)(smem + 57344);
  const int ntile = (nrows / 128) * 8;
  for (int t = blockIdx.x; t < ntile; t += gridDim.x) {
    const int chunk = t >> 3, g = t & 7;
    __syncthreads();
    if (threadIdx.x < 128) rinv[threadIdx.x] = rsqrtf(ssq[chunk * 128 + threadIdx.x] * (1.0f / 2048.0f) + 1e-6f);
    __syncthreads();
    XSguMix xl{p.sgu_w_s + ((size_t)lj * 8 + g) * 128 * 128, rinv};
    const int c0 = g * 256;
    EpiSguMix8 ep{(u16*)(p.ws + OFF_GUZ), p.sgu_gain + (size_t)lj * 2048, p.sgu_b_s + ((size_t)lj * 8 + g) * 128, chunk * 128, c0};
    gemm_tile<1, 8>(xl, (const u16*)(p.ws + OFF_GVT) + ((size_t)chunk * 2048 + c0) * 128, 128, 128, ep, smem);
  }
}

struct XLerp {
  const u16* H; const float* mu; int m0;
  DI u32x4 operator()(int row, int k) const {
    const int grow = m0 + row;
    int pos, len; if (grow < T) { pos = grow & (SEQ - 1); len = SEQ; } else { pos = (grow - T) & (CTXL - 1); len = CTXL; }
    const u16* hp = H + (size_t)grow * D + k;
    const u32x4 c = *(const u32x4*)hp;
    u32x4 a = (u32x4){0u, 0u, 0u, 0u}, b = (u32x4){0u, 0u, 0u, 0u};
    if (pos > 0) a = *(const u32x4*)(hp - D);
    if (pos < len - 1) b = *(const u32x4*)(hp + D);
    const f32x4 m0v = *(const f32x4*)(mu + k), m1v = *(const f32x4*)(mu + k + 4);
    u32x4 o;
#pragma unroll
    for (int e = 0; e < 4; ++e) {
      const float c0 = bflo(c[e]), c1 = bfhi(c[e]);
      const float x0 = 0.5f * (bflo(a[e]) + bflo(b[e])) - c0, x1 = 0.5f * (bfhi(a[e]) + bfhi(b[e])) - c1;
      const float mu0 = e < 2 ? m0v[2 * e] : m1v[2 * e - 4], mu1 = e < 2 ? m0v[2 * e + 1] : m1v[2 * e - 3];
      o[e] = pack2bf(c0 + x0 * mu0, c1 + x1 * mu1);
    }
    return o;
  }
};
template <int NI>
struct EpiF16 {
  h16* O; int ld, m0, n0; bool tanh_;
  DI void operator()(const f32x16 (&acc)[NI], int w, int r, int h) const {
    h16* rowp = O + (size_t)(m0 + 32 * w + r) * ld + n0;
#pragma unroll
    for (int ni = 0; ni < NI; ++ni)
#pragma unroll
      for (int q = 0; q < 4; ++q) {
        h16x4 o;
#pragma unroll
        for (int e = 0; e < 4; ++e) { float v = acc[ni][4 * q + e]; if (tanh_) v = 2.0f * sigmoidf_(2.0f * v) - 1.0f; o[e] = (h16)v; }
        *(h16x4*)(rowp + 32 * ni + 8 * q + 4 * h) = o;
      }
  }
};
DI void phase_rwkv_g(const Params& p, char* smem) {
  const u16* H = (const u16*)(p.ws + OFF_H);
  const u16* W = (const u16*)(p.ws + OFF_W);
  for (int vb = blockIdx.x; (vb >> 3) < 1188; vb += gridDim.x) {
    const int xcd = vb & 7, lg = vb >> 3;
    if (lg < 1056) {
      const int mt = lg >> 1, jt = xcd + 8 * (lg & 1); const int c = jt >> 2, nt = jt & 3;
      XLerp xl{H, p.rwkv_mu + (size_t)c * 1024, mt * 128};
      EpiF16<8> ep{(h16*)(p.ws + OFF_R + (size_t)c * SZ_ACT), 1024, mt * 128, nt * 256, false};
      gemm_tile<1, 8>(xl, W + W_RIN + (size_t)c * 1024 * 1024 + (size_t)nt * 256 * 1024, 1024, 1024, ep, smem);
    } else {
      const int l2 = lg - 1056; const int mt = (l2 >> 1) * 8 + xcd, which = l2 & 1;
      XLerp xl{H, p.rwkv_mu + (size_t)(4 + which) * 1024, mt * 128};
      EpiF16<4> ep{(h16*)(p.ws + (which ? OFF_TA : OFF_TW)), 128, mt * 128, 0, which == 0};
      gemm_tile<1, 4>(xl, W + (which ? W_L1A : W_L1W), 1024, 1024, ep, smem);
    }
  }
}

DI int unit_row0(int u) { const int ch = u % 33, bh = u / 33, b = bh >> 4; return ch == 0 ? T + b * CTXL : b * SEQ + (ch - 1) * 256; }

template <bool PASS_C>
DI void phase_scan(const Params& p, char* smem) {
  const int tid = threadIdx.x, lane = tid & 63, w = tid >> 6, dir = w & 1;
  const bool isP = !PASS_C && (w >> 1);
  float* lb = (float*)(smem + w * 14336);
  float* kkb = lb, *rb = lb + 512, *wb = lb + 1024, *kab = lb + 1536, *kdb = lb + 2048, *vb = lb + 2560, *yob = lb + 3072;
  const h16* Rg = (const h16*)(p.ws + OFF_R); const h16* Kg = (const h16*)(p.ws + OFF_K); const h16* Vg = (const h16*)(p.ws + OFF_V);
  const h16* TWg = (const h16*)(p.ws + OFF_TW); const h16* TAg = (const h16*)(p.ws + OFF_TA);
  h16* Yg = (h16*)(p.ws + OFF_H);
  float* BSg = (float*)(p.ws + OFF_BS);
  h16* SUM = (h16*)(p.ws + OFF_SUMM);
  for (int up = blockIdx.x; up < (PASS_C ? NUNIT / 2 : NUNIT); up += gridDim.x) {
    const int u = PASS_C ? 2 * up + (w >> 1) : up;
    const int hd = (u / 33) & 15, ch = u % 33;
    const int row0 = unit_row0(u);
    const int col = hd * 64 + lane;
    const h16* W2Tw = (const h16*)((const u16*)(p.ws + OFF_W) + W_L2W) + (size_t)dir * 1024 * 64;
    const h16* W2Ta = (const h16*)((const u16*)(p.ws + OFF_W) + W_L2A) + (size_t)dir * 1024 * 64;
    f32x2 S[32];
#pragma unroll
    for (int q = 0; q < 32; ++q) S[q] = (f32x2){0.f, 0.f};
    if (PASS_C) {
      if (ch != 0) {
        const h16* sp = SUM + ((size_t)(u * 2 + dir) * 2 + 0) * 4096 + lane * 64;
#pragma unroll
        for (int q = 0; q < 8; ++q) { const h16x8 v = *(const h16x8*)(sp + 8 * q);
#pragma unroll
          for (int e = 0; e < 4; ++e) S[4 * q + e] = (f32x2){(float)v[2 * e], (float)v[2 * e + 1]}; }
      }
    } else {
#pragma unroll
      for (int q = 0; q < 32; ++q) { if (isP && lane == 2 * q) S[q][0] = 1.f; if (isP && lane == 2 * q + 1) S[q][1] = 1.f; }
    }
    for (int j = 0; j < 32; ++j) {
      const int sb = dir == 0 ? j : 31 - j;
      {
        const int col16 = lane & 15, quad = lane >> 4, ts = col16 & 7, eh = col16 >> 3;
        int w2off = (hd * 64 + col16) * 64 + 8 * quad; asm volatile("" : "+v"(w2off));
        const int tok = row0 + sb * 8 + (dir == 0 ? ts : 7 - ts);
        h16x8 bw[2], ba[2];
#pragma unroll
        for (int ks = 0; ks < 2; ++ks) { bw[ks] = *(const h16x8*)(TWg + (size_t)tok * 128 + dir * 64 + 32 * ks + 8 * quad); ba[ks] = *(const h16x8*)(TAg + (size_t)tok * 128 + dir * 64 + 32 * ks + 8 * quad); }
        f32x4 cw[4], ca[4];
#pragma unroll
        for (int et = 0; et < 4; ++et) {
          cw[et] = (f32x4){0.f, 0.f, 0.f, 0.f}; ca[et] = (f32x4){0.f, 0.f, 0.f, 0.f};
#pragma unroll
          for (int ks = 0; ks < 2; ++ks) {
            const h16x8 aw = *(const h16x8*)(W2Tw + w2off + et * 1024 + 32 * ks);
            const h16x8 aa = *(const h16x8*)(W2Ta + w2off + et * 1024 + 32 * ks);
            cw[et] = __builtin_amdgcn_mfma_f32_16x16x32_f16(aw, bw[ks], cw[et], 0, 0, 0);
            ca[et] = __builtin_amdgcn_mfma_f32_16x16x32_f16(aa, ba[ks], ca[et], 0, 0, 0);
          }
        }
        float ssq = 0.f, bsum = 0.f;
        f32x4 kkr[2], kdv[2], axv[2], decv[2], rxv[2], vxv[2], yov[2];
#pragma unroll
        for (int t = 0; t < 2; ++t) {
          const int e0 = (2 * eh + t) * 16 + 4 * quad; const int c0 = hd * 64 + e0;
          const f32x4 wl4 = eh ? cw[2 + t] : cw[t], al4 = eh ? ca[2 + t] : ca[t];
          const size_t gi = (size_t)tok * 1024 + c0;
          const h16x4 k4 = *(const h16x4*)(Kg + gi), r4 = *(const h16x4*)(Rg + gi), v4 = *(const h16x4*)(Vg + gi);
          h16x4 y4 = (h16x4){(h16)0.f, (h16)0.f, (h16)0.f, (h16)0.f};
          if (PASS_C) { if (j >= 16) y4 = *(const h16x4*)(Yg + gi); }
          const f32x4 w04 = *(const f32x4*)(p.rwkv_w0 + dir * 1024 + c0), a04 = *(const f32x4*)(p.rwkv_a0 + dir * 1024 + c0);
          const f32x4 kk4 = *(const f32x4*)(p.rwkv_k_k + c0), ka4 = *(const f32x4*)(p.rwkv_k_a + c0), rk4 = *(const f32x4*)(p.rwkv_r_k + c0);
#pragma unroll
          for (int e = 0; e < 4; ++e) {
            const float kx = (float)k4[e], rx = (float)r4[e];
            const float kr = kx * kk4[e]; ssq += kr * kr; kkr[t][e] = kr;
            const float nx = -(wl4[e] + w04[e]); const float sp = fmaxf(nx, 0.f) + __logf(1.0f + __expf(-fabsf(nx)));
            decv[t][e] = __expf(-__expf(-sp - 0.5f));
            const float ax = sigmoidf_(al4[e] + a04[e]); axv[t][e] = ax;
            const float kd = kx * (1.0f + (ax - 1.0f) * ka4[e]); kdv[t][e] = kd;
            bsum += rx * kd * rk4[e]; rxv[t][e] = rx; vxv[t][e] = (float)v4[e]; yov[t][e] = (float)y4[e];
          }
        }
        ssq += __shfl_xor(ssq, 8); ssq += __shfl_xor(ssq, 16); ssq += __shfl_xor(ssq, 32);
        const float rn = rsqrtf(ssq + 1e-12f);
#pragma unroll
        for (int t = 0; t < 2; ++t) {
          const int e0 = (2 * eh + t) * 16 + 4 * quad; const int li = ts * 64 + e0;
          const f32x4 kkn = kkr[t] * rn;
          *(f32x4*)(kkb + li) = kkn; *(f32x4*)(rb + li) = rxv[t]; *(f32x4*)(wb + li) = decv[t]; *(f32x4*)(kab + li) = kkn * axv[t]; *(f32x4*)(kdb + li) = kdv[t]; *(f32x4*)(vb + li) = vxv[t];
          if (PASS_C) *(f32x4*)(yob + li) = yov[t];
        }
        if (PASS_C) {
          bsum += __shfl_xor(bsum, 8); bsum += __shfl_xor(bsum, 16); bsum += __shfl_xor(bsum, 32);
          if (lane < 8) BSg[((size_t)tok * 16 + hd) * 2 + dir] = bsum;
        }
      }
      __builtin_amdgcn_s_waitcnt(0xc07f);
#ifndef NO_STEP
#pragma unroll 1
      for (int s = 0; s < 8; ++s) {
        const f32x4* kk4 = (const f32x4*)(kkb + s * 64);
        f32x2 d0 = (f32x2){0.f, 0.f}, d1 = (f32x2){0.f, 0.f};
#pragma unroll
        for (int q = 0; q < 16; ++q) {
          const f32x4 k4 = kk4[q]; const f32x2 klo = (f32x2){k4[0], k4[1]}, khi = (f32x2){k4[2], k4[3]};
          d0 = __builtin_elementwise_fma(S[2 * q], klo, d0); d1 = __builtin_elementwise_fma(S[2 * q + 1], khi, d1);
          if ((q & 3) == 3) __builtin_amdgcn_sched_barrier(0);
        }
        const float a2 = -((d0[0] + d0[1]) + (d1[0] + d1[1]));
        const float a1 = isP ? 0.f : vb[s * 64 + lane];
        const f32x2 a1v = (f32x2){a1, a1}, a2v = (f32x2){a2, a2};
        const f32x4* w4p = (const f32x4*)(wb + s * 64); const f32x4* ka4p = (const f32x4*)(kab + s * 64);
        const f32x4* kd4p = (const f32x4*)(kdb + s * 64); const f32x4* r4p = (const f32x4*)(rb + s * 64);
        f32x2 y0 = (f32x2){0.f, 0.f}, y1 = (f32x2){0.f, 0.f};
#pragma unroll
        for (int q = 0; q < 16; ++q) {
          const f32x4 w4 = w4p[q], ka4 = ka4p[q], kd4 = kd4p[q];
          const f32x2 wlo = (f32x2){w4[0], w4[1]}, whi = (f32x2){w4[2], w4[3]};
          const f32x2 kalo = (f32x2){ka4[0], ka4[1]}, kahi = (f32x2){ka4[2], ka4[3]};
          const f32x2 kdlo = (f32x2){kd4[0], kd4[1]}, kdhi = (f32x2){kd4[2], kd4[3]};
          f32x2 t0 = a1v * kdlo, t1 = a1v * kdhi;
          t0 = __builtin_elementwise_fma(a2v, kalo, t0); t1 = __builtin_elementwise_fma(a2v, kahi, t1);
          S[2 * q] = __builtin_elementwise_fma(S[2 * q], wlo, t0); S[2 * q + 1] = __builtin_elementwise_fma(S[2 * q + 1], whi, t1);
          if (PASS_C) {
            const f32x4 r4 = r4p[q];
            y0 = __builtin_elementwise_fma(S[2 * q], (f32x2){r4[0], r4[1]}, y0); y1 = __builtin_elementwise_fma(S[2 * q + 1], (f32x2){r4[2], r4[3]}, y1);
          }
          if ((q & 1) == 1) __builtin_amdgcn_sched_barrier(0);
        }
        if (PASS_C) {
          float y = (y0[0] + y0[1]) + (y1[0] + y1[1]);
          const int tok = row0 + sb * 8 + (dir == 0 ? s : 7 - s);
          y += yob[s * 64 + lane];
          Yg[(size_t)tok * 1024 + col] = (h16)y;
        }
      }
#endif
      __syncthreads();
    }
    if (!PASS_C) {
      h16* sp = SUM + ((size_t)(u * 2 + dir) * 2 + (isP ? 1 : 0)) * 4096 + lane * 64;
#pragma unroll
      for (int q = 0; q < 8; ++q) {
        h16x8 sv;
#pragma unroll
        for (int e = 0; e < 4; ++e) { sv[2 * e] = (h16)S[4 * q + e][0]; sv[2 * e + 1] = (h16)S[4 * q + e][1]; }
        *(h16x8*)(sp + 8 * q) = sv;
      }
    }
  }
}


DI float dpp_add(float x, const int ctrl_sel) {
  int xi = __builtin_bit_cast(int, x); int yi;
  if (ctrl_sel == 0) yi = __builtin_amdgcn_mov_dpp(xi, 0xB1, 0xf, 0xf, true);
  else if (ctrl_sel == 1) yi = __builtin_amdgcn_mov_dpp(xi, 0x4E, 0xf, 0xf, true);
  else yi = __builtin_amdgcn_mov_dpp(xi, 0x141, 0xf, 0xf, true);
  return x + __builtin_bit_cast(float, yi);
}
DI float red8(float x) { x = dpp_add(x, 0); x = dpp_add(x, 1); x = dpp_add(x, 2); return x; }

struct ScanPre { h16x8 bw[2], ba[2]; h16x4 k4, r4, v4; };

DI void phase_scan_seq(const Params& p, char* smem) {
  int tid_ = threadIdx.x; asm volatile("" : "+v"(tid_));
  const int tid = tid_, lane = tid & 63, w = tid >> 6;
  float* fb = (float*)smem;
  float* part = fb + 2 * 6144;
  float* partb = part + 128;
  float* ybuf = partb + 128;
  const h16* Rg = (const h16*)(p.ws + OFF_R); const h16* Kg = (const h16*)(p.ws + OFF_K); const h16* Vg = (const h16*)(p.ws + OFF_V);
  const h16* TWg = (const h16*)(p.ws + OFF_TW); const h16* TAg = (const h16*)(p.ws + OFF_TA);
  float* BSg = (float*)(p.ws + OFF_BS);
  const int ts = lane & 15, quad = lane >> 4;
  const int rowl = w * 16 + (lane >> 2), kq = lane & 3;
  constexpr int NST = 528;
  for (int u = blockIdx.x; u < 256; u += gridDim.x) {
    const int chain = u, dir = chain & 1, bh = chain >> 1, b = bh >> 4, hd = bh & 15;
    h16* Yg = (h16*)(p.ws + (dir == 0 ? OFF_H : OFF_Y1));
    const int e0 = 16 * w + 4 * quad;
    const int c0 = hd * 64 + e0;
    h16x8 aw[2], aa[2];
    {
      const h16* W2Tw = (const h16*)((const u16*)(p.ws + OFF_W) + W_L2W) + (size_t)dir * 1024 * 64 + (size_t)(hd * 64 + 16 * w + ts) * 64 + 8 * quad;
      const h16* W2Ta = (const h16*)((const u16*)(p.ws + OFF_W) + W_L2A) + (size_t)dir * 1024 * 64 + (size_t)(hd * 64 + 16 * w + ts) * 64 + 8 * quad;
      aw[0] = *(const h16x8*)W2Tw; aw[1] = *(const h16x8*)(W2Tw + 32); aa[0] = *(const h16x8*)W2Ta; aa[1] = *(const h16x8*)(W2Ta + 32);
    }
    const f32x4 w0c = *(const f32x4*)(p.rwkv_w0 + dir * 1024 + c0), a0c = *(const f32x4*)(p.rwkv_a0 + dir * 1024 + c0);
    const f32x4 kkc = *(const f32x4*)(p.rwkv_k_k + c0), kac = *(const f32x4*)(p.rwkv_k_a + c0), rkc = *(const f32x4*)(p.rwkv_r_k + c0);
    auto stage_row = [&](int st) -> int {
      if (st < 16) return T + b * CTXL + (dir == 0 ? st : 15 - st) * 16;
      const int q = st - 16; return b * SEQ + (dir == 0 ? q : 511 - q) * 16;
    };
    auto pre_load = [&](int st) -> ScanPre {
      ScanPre pr; const int tok = stage_row(st) + (dir == 0 ? ts : 15 - ts);
      const h16* twp = TWg + (size_t)tok * 128 + dir * 64 + 8 * quad; const h16* tap = TAg + (size_t)tok * 128 + dir * 64 + 8 * quad;
      pr.bw[0] = *(const h16x8*)twp; pr.bw[1] = *(const h16x8*)(twp + 32); pr.ba[0] = *(const h16x8*)tap; pr.ba[1] = *(const h16x8*)(tap + 32);
      const size_t gi = (size_t)tok * 1024 + c0;
      pr.k4 = *(const h16x4*)(Kg + gi); pr.r4 = *(const h16x4*)(Rg + gi); pr.v4 = *(const h16x4*)(Vg + gi);
      return pr;
    };
    auto pre_compute = [&](const ScanPre& pr, int buf) {
      f32x4 cw = (f32x4){0.f, 0.f, 0.f, 0.f}, ca = (f32x4){0.f, 0.f, 0.f, 0.f};
#pragma unroll
      for (int ks = 0; ks < 2; ++ks) { cw = __builtin_amdgcn_mfma_f32_16x16x32_f16(aw[ks], pr.bw[ks], cw, 0, 0, 0); ca = __builtin_amdgcn_mfma_f32_16x16x32_f16(aa[ks], pr.ba[ks], ca, 0, 0, 0); }
      float* B = fb + buf * 6144 + ts * 64 + e0;
      f32x4 kkr, rx, vx, dec, kar, kd; float ssq = 0.f, bsum = 0.f;
#pragma unroll
      for (int e = 0; e < 4; ++e) {
        const float wl = cw[e] + w0c[e], al = ca[e] + a0c[e];
        const float kx = (float)pr.k4[e]; rx[e] = (float)pr.r4[e]; vx[e] = (float)pr.v4[e];
        const float kr = kx * kkc[e]; kkr[e] = kr; ssq += kr * kr;
        const float nx = -wl; const float sp = fmaxf(nx, 0.f) + __logf(1.0f + __expf(-fabsf(nx)));
        dec[e] = __expf(-__expf(-sp - 0.5f));
        const float ax = sigmoidf_(al);
        kd[e] = kx * (1.0f + (ax - 1.0f) * kac[e]); kar[e] = kr * ax;
        bsum += rx[e] * kd[e] * rkc[e];
      }
      *(f32x4*)(B) = kkr; *(f32x4*)(B + 1024) = rx; *(f32x4*)(B + 2048) = dec; *(f32x4*)(B + 3072) = kar; *(f32x4*)(B + 4096) = kd; *(f32x4*)(B + 5120) = vx;
      ssq += __shfl_xor(ssq, 16); ssq += __shfl_xor(ssq, 32);
      bsum += __shfl_xor(bsum, 16); bsum += __shfl_xor(bsum, 32);
      if (lane < 16) { part[(buf * 16 + ts) * 4 + w] = ssq; partb[(buf * 16 + ts) * 4 + w] = bsum; }
    };
    f32x2 S[8];
#pragma unroll
    for (int i = 0; i < 8; ++i) S[i] = (f32x2){0.f, 0.f};
    __syncthreads();
    { const ScanPre pr = pre_load(0); pre_compute(pr, 0); }
    __syncthreads();
#pragma unroll 1
    for (int st = 0; st < NST; ++st) {
      const int cur = st & 1;
      ScanPre pr; const bool more = st + 1 < NST;
      if (more) pr = pre_load(st + 1);
      if (tid < 16) {
        const f32x4 pb = *(const f32x4*)(partb + (cur * 16 + tid) * 4);
        const int tok = stage_row(st) + (dir == 0 ? tid : 15 - tid);
        BSg[((size_t)tok * 16 + hd) * 2 + dir] = (pb[0] + pb[1]) + (pb[2] + pb[3]);
      }
      const float* B = fb + cur * 6144;
      float* yb = ybuf + cur * 1024;
#pragma unroll 8
      for (int s = 0; s < 16; ++s) {
        const float* Bs = B + s * 64 + 16 * kq;
        f32x4 kk[4], ww[4], ka[4], kd[4], rr[4];
#pragma unroll
        for (int q = 0; q < 4; ++q) { kk[q] = *(const f32x4*)(Bs + 4 * q); ww[q] = *(const f32x4*)(Bs + 2048 + 4 * q); ka[q] = *(const f32x4*)(Bs + 3072 + 4 * q); kd[q] = *(const f32x4*)(Bs + 4096 + 4 * q); rr[q] = *(const f32x4*)(Bs + 1024 + 4 * q); }
        const f32x4 pr4 = *(const f32x4*)(part + (cur * 16 + s) * 4);
        const float a1 = B[5120 + s * 64 + rowl];
        f32x2 d0 = S[0] * (f32x2){kk[0][0], kk[0][1]}, d1 = S[1] * (f32x2){kk[0][2], kk[0][3]};
#pragma unroll
        for (int q = 1; q < 4; ++q) { d0 = __builtin_elementwise_fma(S[2 * q], (f32x2){kk[q][0], kk[q][1]}, d0); d1 = __builtin_elementwise_fma(S[2 * q + 1], (f32x2){kk[q][2], kk[q][3]}, d1); }
        float x = (d0[0] + d0[1]) + (d1[0] + d1[1]); x = dpp_add(x, 0); x = dpp_add(x, 1);
        const float rn2 = __builtin_amdgcn_rcpf((pr4[0] + pr4[1]) + (pr4[2] + pr4[3]) + 1e-12f);
        const float a2 = -x * rn2;
        const f32x2 a1v = (f32x2){a1, a1}, a2v = (f32x2){a2, a2};
        f32x2 y0 = (f32x2){0.f, 0.f}, y1 = (f32x2){0.f, 0.f};
#pragma unroll
        for (int q = 0; q < 4; ++q) {
          f32x2 t0 = __builtin_elementwise_fma(a2v, (f32x2){ka[q][0], ka[q][1]}, a1v * (f32x2){kd[q][0], kd[q][1]});
          f32x2 t1 = __builtin_elementwise_fma(a2v, (f32x2){ka[q][2], ka[q][3]}, a1v * (f32x2){kd[q][2], kd[q][3]});
          S[2 * q] = __builtin_elementwise_fma(S[2 * q], (f32x2){ww[q][0], ww[q][1]}, t0);
          S[2 * q + 1] = __builtin_elementwise_fma(S[2 * q + 1], (f32x2){ww[q][2], ww[q][3]}, t1);
          y0 = __builtin_elementwise_fma(S[2 * q], (f32x2){rr[q][0], rr[q][1]}, y0);
          y1 = __builtin_elementwise_fma(S[2 * q + 1], (f32x2){rr[q][2], rr[q][3]}, y1);
        }
        float y = (y0[0] + y0[1]) + (y1[0] + y1[1]); y = dpp_add(y, 0); y = dpp_add(y, 1);
        if (kq == 0) yb[s * 64 + rowl] = y;
      }
      if (more) pre_compute(pr, cur ^ 1);
      __syncthreads();
#pragma unroll
      for (int hh = 0; hh < 4; ++hh) { const int s = (tid >> 6) + 4 * hh, vl = tid & 63; const int tok = stage_row(st) + (dir == 0 ? s : 15 - s);
        Yg[(size_t)tok * 1024 + hd * 64 + vl] = (h16)yb[s * 64 + vl]; }
    }
    __syncthreads();
  }
}

DI void phase_combine(const Params& p, char* smem) {
  const int tid = threadIdx.x, v = tid >> 2, kq = tid & 3;
  float* curs = (float*)smem;
  float* Ps = (float*)(smem + 64 * 68 * 4);
  h16* SUM = (h16*)(p.ws + OFF_SUMM);
  for (int cidx = blockIdx.x; cidx < 256; cidx += gridDim.x) {
    const int dir = cidx & 1, bh = cidx >> 1;
    float cur[16];
#pragma unroll
    for (int e = 0; e < 16; ++e) cur[e] = 0.f;
    for (int i = 0; i < 33; ++i) {
      const int ch = i == 0 ? 0 : (dir == 0 ? i : 33 - i);
      const int u = bh * 33 + ch;
      h16* sp = SUM + ((size_t)(u * 2 + dir) * 2) * 4096;
      const h16x8 se0 = *(const h16x8*)(sp + v * 64 + kq * 16), se1 = *(const h16x8*)(sp + v * 64 + kq * 16 + 8);
      const h16x8 pe0 = *(const h16x8*)(sp + 4096 + v * 64 + kq * 16), pe1 = *(const h16x8*)(sp + 4096 + v * 64 + kq * 16 + 8);
      __syncthreads();
      h16x8 c0, c1;
#pragma unroll
      for (int e = 0; e < 8; ++e) { c0[e] = (h16)cur[e]; c1[e] = (h16)cur[8 + e]; curs[v * 68 + kq * 16 + e] = cur[e]; curs[v * 68 + kq * 16 + 8 + e] = cur[8 + e];
        Ps[v * 64 + kq * 16 + e] = (float)pe0[e]; Ps[v * 64 + kq * 16 + 8 + e] = (float)pe1[e]; }
      *(h16x8*)(sp + v * 64 + kq * 16) = c0; *(h16x8*)(sp + v * 64 + kq * 16 + 8) = c1;
      __syncthreads();
      float nw[16];
#pragma unroll
      for (int e = 0; e < 8; ++e) { nw[e] = (float)se0[e]; nw[8 + e] = (float)se1[e]; }
      for (int jj = 0; jj < 64; jj += 4) {
        const f32x4 cv = *(const f32x4*)(curs + v * 68 + jj);
#pragma unroll
        for (int e4 = 0; e4 < 4; ++e4) {
          const float cs = cv[e4];
#pragma unroll
          for (int q = 0; q < 4; ++q) { const f32x4 pv = *(const f32x4*)(Ps + (jj + e4) * 64 + kq * 16 + 4 * q);
#pragma unroll
            for (int e = 0; e < 4; ++e) nw[4 * q + e] += cs * pv[e]; }
        }
      }
#pragma unroll
      for (int e = 0; e < 16; ++e) cur[e] = nw[e];
    }
    __syncthreads();
  }
}

DI void phase_rwkv_ln(const Params& p) {
  const int lane = threadIdx.x & 63, w = threadIdx.x >> 6, hd = lane >> 2;
  const h16* Yg = (const h16*)(p.ws + OFF_H); const h16* Y1g = (const h16*)(p.ws + OFF_Y1); const h16* Vg = (const h16*)(p.ws + OFF_V);
  h16* Zg = (h16*)(p.ws + OFF_Z); const float* BSg = (const float*)(p.ws + OFF_BS);
  const int c0 = lane * 16;
  for (int row = blockIdx.x * 4 + w; row < MALL; row += gridDim.x * 4) {
    const size_t gi = (size_t)row * 1024 + c0;
    float y[16], vv[16], zz[16];
#pragma unroll
    for (int q = 0; q < 2; ++q) { const h16x8 a = *(const h16x8*)(Yg + gi + 8 * q), a1 = *(const h16x8*)(Y1g + gi + 8 * q), b = *(const h16x8*)(Vg + gi + 8 * q), c = *(const h16x8*)(Zg + gi + 8 * q);
#pragma unroll
      for (int e = 0; e < 8; ++e) { y[8 * q + e] = (float)a[e] + (float)a1[e]; vv[8 * q + e] = (float)b[e]; zz[8 * q + e] = (float)c[e]; } }
    float s = 0.f;
#pragma unroll
    for (int e = 0; e < 16; ++e) s += y[e];
    s += __shfl_xor(s, 1); s += __shfl_xor(s, 2);
    const float mean = s * (1.0f / 64.0f);
    float q2 = 0.f;
#pragma unroll
    for (int e = 0; e < 16; ++e) { const float d = y[e] - mean; q2 += d * d; }
    q2 += __shfl_xor(q2, 1); q2 += __shfl_xor(q2, 2);
    const float rstd = rsqrtf(q2 * (1.0f / 64.0f) + 64e-5f);
    const float bon = BSg[((size_t)row * 16 + hd) * 2] + BSg[((size_t)row * 16 + hd) * 2 + 1];
    unsigned o[8];
#pragma unroll
    for (int e = 0; e < 8; ++e) {
      float t0 = (y[2 * e] - mean) * rstd * p.rwkv_ln_gain[c0 + 2 * e] + p.rwkv_ln_bias[c0 + 2 * e] + bon * vv[2 * e];
      float t1 = (y[2 * e + 1] - mean) * rstd * p.rwkv_ln_gain[c0 + 2 * e + 1] + p.rwkv_ln_bias[c0 + 2 * e + 1] + bon * vv[2 * e + 1];
      o[e] = pack2bf(t0 * siluf_(zz[2 * e]), t1 * siluf_(zz[2 * e + 1]));
    }
    u32x4* op = (u32x4*)(Zg + gi);
    op[0] = (u32x4){o[0], o[1], o[2], o[3]}; op[1] = (u32x4){o[4], o[5], o[6], o[7]};
  }
}

struct EpiMlaIn {
  const Params* p; int m0, nt;
  DI void operator()(const f32x16 (&acc)[4], int w, int r, int h) const {
    const int row = m0 + 32 * w + r;
    if (nt < 8) {
      float ss = 0.f;
      u16* O = nt < 6 ? (u16*)(p->ws + OFF_CQ) + (size_t)row * 768 + nt * 128 : (u16*)(p->ws + OFF_CKV) + (size_t)row * 256 + (nt - 6) * 128;
#pragma unroll
      for (int ni = 0; ni < 4; ++ni)
#pragma unroll
        for (int q = 0; q < 4; ++q) {
          const float a0 = acc[ni][4 * q], a1 = acc[ni][4 * q + 1], a2 = acc[ni][4 * q + 2], a3 = acc[ni][4 * q + 3];
          ss += a0 * a0 + a1 * a1 + a2 * a2 + a3 * a3;
          *(u32x2*)(O + 32 * ni + 8 * q + 4 * h) = (u32x2){pack2bf(a0, a1), pack2bf(a2, a3)};
        }
      ss += __shfl_xor(ss, 32);
      if (h == 0) atomicAdd((float*)(p->ws + (nt < 6 ? OFF_SSQA : OFF_SSQB)) + row, ss);
    } else if (nt < 24) {
      u16* O = (u16*)(p->ws + OFF_SZ) + (size_t)row * 2048 + (nt - 8) * 128;
#pragma unroll
      for (int ni = 0; ni < 4; ++ni)
#pragma unroll
        for (int q = 0; q < 4; ++q)
          *(u32x2*)(O + 32 * ni + 8 * q + 4 * h) = (u32x2){pack2bf(siluf_(acc[ni][4 * q]), siluf_(acc[ni][4 * q + 1])), pack2bf(siluf_(acc[ni][4 * q + 2]), siluf_(acc[ni][4 * q + 3]))};
    } else {
      float* O = (float*)(p->ws + OFF_KR) + (size_t)row * 64; float ss = 0.f;
#pragma unroll
      for (int ni = 0; ni < 2; ++ni)
#pragma unroll
        for (int q = 0; q < 4; ++q) {
          f32x4 o;
#pragma unroll
          for (int e = 0; e < 4; ++e) { o[e] = acc[ni][4 * q + e]; ss += o[e] * o[e]; }
          *(f32x4*)(O + 32 * ni + 8 * q + 4 * h) = o;
        }
      ss += __shfl_xor(ss, 32);
      if (h == 0) ((float*)(p->ws + OFF_SSQR))[row] = ss;
    }
  }
};
DI void phase_mla_in(const Params& p, char* smem) {
  const u16* H = (const u16*)(p.ws + OFF_H);
  const u16* Wt = (const u16*)(p.ws + OFF_W) + W_MIN;
  for (int vb = blockIdx.x; (vb >> 3) < 803; vb += gridDim.x) {
    const int xcd = vb & 7, lg = vb >> 3;
    int mt, nt;
    if (lg < 768) { mt = lg / 3; nt = xcd + 8 * (lg % 3); }
    else if (lg < 800) { mt = (lg - 768) * 8 + xcd; nt = 24; }
    else { const int q = (lg - 800) * 8 + xcd; mt = 256 + q / 3; const int s = q % 3; nt = s == 0 ? 6 : (s == 1 ? 7 : 24); }
    EpiMlaIn ep{&p, mt * 256, nt};
    gemm_tile_glds(H + (size_t)mt * 256 * D, D, Wt + (size_t)nt * 128 * D, D, D, ep, smem);
  }
}

constexpr float QSCALE = 0.07216878364870322f * 1.4426950408889634f;
struct EpiMlaQ {
  const Params* p; int grow0  , lrow0  , head;
  DI void operator()(const f32x16 (&acc)[6], int w, int r, int h) const {
    const int row = grow0 + 32 * w + r, lrow = lrow0 + 32 * w + r;
    const float rq = rsqrtf(((const float*)(p->ws + OFF_SSQA))[row] * (1.0f / 768.0f) + 1e-6f);
    float ss = 0.f;
#pragma unroll
    for (int ni = 0; ni < 6; ++ni)
#pragma unroll
      for (int i = 0; i < 16; ++i) { const float v = acc[ni][i] * rq; ss += v * v; }
    ss += __shfl_xor(ss, 32);
    const float sc = rq * rsqrtf(ss * (1.0f / 192.0f) + 1e-6f) * QSCALE;
    const float* gq = p->mla_qk_gain_q;
    u16* O = (u16*)(p->ws + OFF_QX) + ((size_t)lrow * 16 + head) * 256;
#pragma unroll
    for (int ni = 0; ni < 4; ++ni)
#pragma unroll
      for (int q = 0; q < 4; ++q) {
        const int n = 32 * ni + 8 * q + 4 * h; const f32x4 g = *(const f32x4*)(gq + n);
        *(u32x2*)(O + n) = (u32x2){pack2bf(acc[ni][4 * q] * sc * g[0], acc[ni][4 * q + 1] * sc * g[1]), pack2bf(acc[ni][4 * q + 2] * sc * g[2], acc[ni][4 * q + 3] * sc * g[3])};
      }
    const int pos = row & (SEQ - 1); const int prow = pos >> 6, pcol = pos & 63;
    const f32x2* cs = (const f32x2*)(p->ws + OFF_CS);
#pragma unroll
    for (int q = 0; q < 4; ++q) {
      const int pb = 8 * q + 4 * h;
      float x1[4], x2[4], o1[4], o2[4];
#pragma unroll
      for (int e = 0; e < 4; ++e) {
        const int pi = pb + e;
        x1[e] = acc[4][4 * q + e] * sc * gq[128 + pi]; x2[e] = acc[5][4 * q + e] * sc * gq[160 + pi];
        const f32x2 c = pi < 16 ? cs[prow * 16 + pi] : cs[2048 + pcol * 16 + (pi - 16)];
        o1[e] = x1[e] * c[0] - x2[e] * c[1]; o2[e] = x1[e] * c[1] + x2[e] * c[0];
      }
      *(u32x2*)(O + 128 + pb) = (u32x2){pack2bf(o1[0], o1[1]), pack2bf(o1[2], o1[3])};
      *(u32x2*)(O + 160 + pb) = (u32x2){pack2bf(o2[0], o2[1]), pack2bf(o2[2], o2[3])};
      *(u32x2*)(O + 192 + pb) = (u32x2){pack2bf(x1[0], x1[1]), pack2bf(x1[2], x1[3])};
      *(u32x2*)(O + 224 + pb) = (u32x2){pack2bf(x2[0], x2[1]), pack2bf(x2[2], x2[3])};
    }
  }
};
struct EpiMlaKV {
  const Params* p; int grow0, kvrow0  , head, isv, blocal;
  DI void operator()(const f32x16 (&acc)[4], int w, int r, int h) const {
    const int row = grow0 + 32 * w + r, kvrow = kvrow0 + 32 * w + r;
    const float rkv = rsqrtf(((const float*)(p->ws + OFF_SSQB))[row] * (1.0f / 256.0f) + 1e-6f);
    if (isv) {
      u16* O = (u16*)(p->ws + OFF_VT) + ((size_t)(blocal * 16 + head) * 128) * 8448 + (kvrow - blocal * 8448);
#pragma unroll
      for (int ni = 0; ni < 4; ++ni)
#pragma unroll
        for (int i = 0; i < 16; ++i) O[(size_t)(32 * ni + crow(i, h)) * 8448] = f2bf(acc[ni][i] * rkv);
      return;
    }
    float ss = 0.f;
#pragma unroll
    for (int ni = 0; ni < 4; ++ni)
#pragma unroll
      for (int i = 0; i < 16; ++i) { const float v = acc[ni][i] * rkv; ss += v * v; }
    ss += __shfl_xor(ss, 32);
    ss += ((const float*)(p->ws + OFF_SSQR))[row];
    const float rn = rsqrtf(ss * (1.0f / 192.0f) + 1e-6f); const float sc = rkv * rn;
    const float* gk = p->mla_qk_gain_k;
    u16* O = (u16*)(p->ws + OFF_KX) + ((size_t)kvrow * 16 + head) * 192;
#pragma unroll
    for (int ni = 0; ni < 4; ++ni)
#pragma unroll
      for (int q = 0; q < 4; ++q) {
        const int n = 32 * ni + 8 * q + 4 * h; const f32x4 g = *(const f32x4*)(gk + n);
        *(u32x2*)(O + n) = (u32x2){pack2bf(acc[ni][4 * q] * sc * g[0], acc[ni][4 * q + 1] * sc * g[1]), pack2bf(acc[ni][4 * q + 2] * sc * g[2], acc[ni][4 * q + 3] * sc * g[3])};
      }
    const float* kr = (const float*)(p->ws + OFF_KR) + (size_t)row * 64;
    const bool lat = row < T; const int pos = row & (SEQ - 1);
    const f32x2* cs = (const f32x2*)(p->ws + OFF_CS) + (h == 0 ? (pos >> 6) * 16 : 2048 + (pos & 63) * 16);
    unsigned o1[8], o2[8];
#pragma unroll
    for (int e = 0; e < 8; ++e) {
      float a[2], b[2];
#pragma unroll
      for (int t = 0; t < 2; ++t) {
        const int pi = 16 * h + 2 * e + t;
        const float x1 = kr[pi] * rn * gk[128 + pi], x2 = kr[32 + pi] * rn * gk[160 + pi];
        f32x2 c = (f32x2){1.f, 0.f}; if (lat) c = cs[2 * e + t];
        a[t] = x1 * c[0] - x2 * c[1]; b[t] = x1 * c[1] + x2 * c[0];
      }
      o1[e] = pack2bf(a[0], a[1]); o2[e] = pack2bf(b[0], b[1]);
    }
    u32x4* d1 = (u32x4*)(O + 128 + 16 * h); u32x4* d2 = (u32x4*)(O + 160 + 16 * h);
    d1[0] = (u32x4){o1[0], o1[1], o1[2], o1[3]}; d1[1] = (u32x4){o1[4], o1[5], o1[6], o1[7]};
    d2[0] = (u32x4){o2[0], o2[1], o2[2], o2[3]}; d2[1] = (u32x4){o2[4], o2[5], o2[6], o2[7]};
  }
};
struct EpiMlaKV8 {
  EpiMlaKV k, v;
  DI void operator()(const f32x16 (&acc)[8], int w, int r, int h) const {
    v(reinterpret_cast<const f32x16 (&)[4]>(acc[4]), w, r, h);
    __builtin_amdgcn_sched_barrier(0);
    k(reinterpret_cast<const f32x16 (&)[4]>(acc[0]), w, r, h);
  }
};
DI void phase_mla_up(const Params& p, int g, char* smem) {
  const u16* W = (const u16*)(p.ws + OFF_W);
  const int nq = 128 * 16, nkv = 132 * 16;
  for (int t = blockIdx.x; t < nq + nkv; t += gridDim.x) {
    if (t < nq) {
      const int mt = t >> 4, head = t & 15;
      const int grow0 = g * 16384 + mt * 128;
      XPlain xl{(const u16*)(p.ws + OFF_CQ) + (size_t)grow0 * 768, 768};
      EpiMlaQ ep{&p, grow0, mt * 128, head};
      gemm_tile<1, 6>(xl, W + W_UQ + (size_t)head * 192 * 768, 768, 768, ep, smem);
    } else {
      const int q = t - nq; const int mt = q >> 4, head = q & 15;
      int grow0, kvrow0, blocal;
      if (mt < 128) { blocal = mt >> 6; grow0 = g * 16384 + mt * 128; kvrow0 = blocal * 8448 + 256 + (mt & 63) * 128; }
      else { const int cm = mt - 128; blocal = cm >> 1; grow0 = T + (g * 2 + blocal) * 256 + (cm & 1) * 128; kvrow0 = blocal * 8448 + (cm & 1) * 128; }
      XPlain xl{(const u16*)(p.ws + OFF_CKV) + (size_t)grow0 * 256, 256};
      EpiMlaKV8 ep{EpiMlaKV{&p, grow0, kvrow0, head, 0, blocal}, EpiMlaKV{&p, grow0, kvrow0, head, 1, blocal}};
      gemm_tile<1, 8>(xl, W + W_UKV + (size_t)head * 256 * 256, 256, 256, ep, smem);
    }
  }
}

DI int kswap(int r) { return (r & ~12) | ((r & 4) << 1) | ((r & 8) >> 1); }
constexpr int KROW = 400;
DI void phase_attn(const Params& p, int g, char* smem, bool dry = false) {
  int tid_ = threadIdx.x; asm volatile("" : "+v"(tid_));
  const int tid = tid_, lane = tid & 63, w = tid >> 6, r = lane & 31, h = lane >> 5;
  char* Ks = smem; char* Vs = smem + 64 * KROW;
  const u16* QX = (const u16*)(p.ws + OFF_QX); const u16* KX = (const u16*)(p.ws + OFF_KX); const u16* VT = (const u16*)(p.ws + OFF_VT);
  u16* SZ = (u16*)(p.ws + OFF_SZ);
  const int ksr = kswap(r);
  for (int uu = blockIdx.x; uu < 2048; uu += gridDim.x) {
    const int xcd = uu & 7, lg = uu >> 3; const int bh = (lg >> 6) * 8 + xcd;
    const int qb = lg & 63, head = bh & 15, blocal = bh >> 4;
    const int lq = blocal * 8192 + qb * 128 + 32 * w + r;
    const u16* qp = QX + ((size_t)lq * 16 + head) * 256;
    bf16x8 qf[12];
#pragma unroll
    for (int ds = 0; ds < 8; ++ds) qf[ds] = *(const bf16x8*)(qp + 16 * ds + 8 * h);
#pragma unroll
    for (int ds = 0; ds < 4; ++ds) qf[8 + ds] = *(const bf16x8*)(qp + 192 + 16 * ds + 8 * h);
    f32x16 O[4];
#pragma unroll
    for (int di = 0; di < 4; ++di)
#pragma unroll
      for (int i = 0; i < 16; ++i) O[di][i] = 0.f;
    float m = -1e30f, l = 0.f;
    const u16* kbase = KX + ((size_t)blocal * 8448 * 16 + head) * 192;
    const u16* vbase = VT + (size_t)(blocal * 16 + head) * 128 * 8448;
    u32x4 kr_[6], vr_[4];
    const u16* kptr = kbase + (size_t)(tid >> 2) * 3072 + (tid & 3) * 8;
    const u16* vptr = vbase + (size_t)(tid >> 1) * 8448 + (tid & 1) * 32;
    char* kls = Ks + (tid >> 2) * KROW + (tid & 3) * 16;
    char* vls = Vs + (tid >> 1) * LROW + (tid & 1) * 64;
#pragma unroll
    for (int j = 0; j < 6; ++j) kr_[j] = *(const u32x4*)(kptr + 32 * j);
#pragma unroll
    for (int j = 0; j < 4; ++j) vr_[j] = *(const u32x4*)(vptr + 8 * j);
#pragma unroll 1
    for (int kt = 0; kt < 132; ++kt) {
      __syncthreads();
#pragma unroll
      for (int j = 0; j < 6; ++j) *(u32x4*)(kls + 64 * j) = kr_[j];
#pragma unroll
      for (int j = 0; j < 4; ++j) *(u32x4*)(vls + 16 * j) = vr_[j];
      __syncthreads();
      if (kt + 1 < 132) {
        kptr += 64 * 3072; vptr += 64;
#pragma unroll
        for (int j = 0; j < 6; ++j) kr_[j] = *(const u32x4*)(kptr + 32 * j);
#pragma unroll
        for (int j = 0; j < 4; ++j) vr_[j] = *(const u32x4*)(vptr + 8 * j);
      }
      if (kt == 4) {
#pragma unroll
        for (int ds = 0; ds < 4; ++ds) qf[8 + ds] = *(const bf16x8*)(qp + 128 + 16 * ds + 8 * h);
      }
      f32x16 St[2];
      __builtin_amdgcn_s_setprio(1);
#pragma unroll
      for (int kb = 0; kb < 2; ++kb) {
#pragma unroll
        for (int i = 0; i < 16; ++i) St[kb][i] = 0.f;
#pragma unroll
        for (int ds = 0; ds < 12; ++ds) {
          const bf16x8 kf = *(const bf16x8*)(Ks + (32 * kb + ksr) * KROW + (16 * ds + 8 * h) * 2);
          St[kb] = MFMA(kf, qf[ds], St[kb]);
          if ((ds & 3) == 3) __builtin_amdgcn_sched_barrier(0);
        }
      }
      __builtin_amdgcn_s_setprio(0);
      asm volatile("s_nop 7\n\ts_nop 7" ::: "memory");
      float mx = St[0][0];
#pragma unroll
      for (int kb = 0; kb < 2; ++kb)
#pragma unroll
        for (int i = 0; i < 16; ++i) mx = fmaxf(mx, St[kb][i]);
      mx = fmaxf(mx, __shfl_xor(mx, 32));
      const float mn = fmaxf(m, mx); const float alpha = __builtin_amdgcn_exp2f(m - mn); m = mn;
      St[0] = St[0] - mn; St[1] = St[1] - mn;
#pragma unroll
      for (int kb = 0; kb < 2; ++kb)
#pragma unroll
        for (int i = 0; i < 16; ++i) St[kb][i] = __builtin_amdgcn_exp2f(St[kb][i]);
      float ls;
      { const f32x16 t = St[0] + St[1];
        const f32x4 a = (f32x4){t[0], t[1], t[2], t[3]} + (f32x4){t[4], t[5], t[6], t[7]} + (f32x4){t[8], t[9], t[10], t[11]} + (f32x4){t[12], t[13], t[14], t[15]};
        ls = (a[0] + a[1]) + (a[2] + a[3]); }
      l = l * alpha + ls;
      if (__builtin_amdgcn_ballot_w64(alpha != 1.0f) != 0ull) {
#pragma unroll
        for (int di = 0; di < 4; ++di)
#pragma unroll
          for (int i = 0; i < 16; ++i) O[di][i] *= alpha;
      }
      __builtin_amdgcn_s_setprio(1);
#pragma unroll
      for (int kb = 0; kb < 2; ++kb)
#pragma unroll
        for (int s = 0; s < 2; ++s) {
          u32x4 pk;
#pragma unroll
          for (int e = 0; e < 4; ++e) pk[e] = pack2bf(St[kb][8 * s + 2 * e], St[kb][8 * s + 2 * e + 1]);
          const bf16x8 pf = __builtin_bit_cast(bf16x8, pk);
#pragma unroll
          for (int di = 0; di < 4; ++di) {
            const bf16x8 vf = *(const bf16x8*)(Vs + (32 * di + r) * LROW + (32 * kb + 16 * s + 8 * h) * 2);
            O[di] = MFMA(vf, pf, O[di]);
          }
          __builtin_amdgcn_sched_barrier(0);
        }
      __builtin_amdgcn_s_setprio(0);
      asm volatile("s_nop 7\n\ts_nop 7" ::: "memory");
    }
    l += __shfl_xor(l, 32);
    const float inv = 1.0f / l;
    const int grow = g * 16384 + lq;
    u16* op = SZ + (size_t)grow * 2048 + head * 128;
    if (dry && l > 0.f) continue;
#pragma unroll
    for (int di = 0; di < 4; ++di)
#pragma unroll
      for (int q = 0; q < 4; ++q) {
        const int n = 32 * di + 8 * q + 4 * h;
        const u32x2 z = *(const u32x2*)(op + n);
        *(u32x2*)(op + n) = (u32x2){pack2bf(O[di][4 * q] * inv * bflo(z[0]), O[di][4 * q + 1] * inv * bfhi(z[0])), pack2bf(O[di][4 * q + 2] * inv * bflo(z[1]), O[di][4 * q + 3] * inv * bfhi(z[1]))};
      }
  }
}

typedef const volatile __attribute__((address_space(4))) unsigned long long* kargp_t;
DI Params ldp() {
  kargp_t kp = (kargp_t)__builtin_amdgcn_kernarg_segment_ptr();
  Params q;
  q.x = (const float*)(const __attribute__((address_space(1))) float*)kp[0];
  q.c = (const float*)(const __attribute__((address_space(1))) float*)kp[1];
  q.ctx = (const float*)(const __attribute__((address_space(1))) float*)kp[2];
  q.c_ctx = (const float*)(const __attribute__((address_space(1))) float*)kp[3];
  q.ada_w = (const float*)(const __attribute__((address_space(1))) float*)kp[4];
  q.ada_b = (const float*)(const __attribute__((address_space(1))) float*)kp[5];
  q.sgu_w_in = (const float*)(const __attribute__((address_space(1))) float*)kp[6];
  q.sgu_gain = (const float*)(const __attribute__((address_space(1))) float*)kp[7];
  q.sgu_w_s = (const float*)(const __attribute__((address_space(1))) float*)kp[8];
  q.sgu_b_s = (const float*)(const __attribute__((address_space(1))) float*)kp[9];
  q.sgu_w_out = (const float*)(const __attribute__((address_space(1))) float*)kp[10];
  q.rwkv_mu = (const float*)(const __attribute__((address_space(1))) float*)kp[11];
  q.rwkv_w_in = (const float*)(const __attribute__((address_space(1))) float*)kp[12];
  q.rwkv_w_lora1 = (const float*)(const __attribute__((address_space(1))) float*)kp[13];
  q.rwkv_w_lora2 = (const float*)(const __attribute__((address_space(1))) float*)kp[14];
  q.rwkv_w0 = (const float*)(const __attribute__((address_space(1))) float*)kp[15];
  q.rwkv_a_lora1 = (const float*)(const __attribute__((address_space(1))) float*)kp[16];
  q.rwkv_a_lora2 = (const float*)(const __attribute__((address_space(1))) float*)kp[17];
  q.rwkv_a0 = (const float*)(const __attribute__((address_space(1))) float*)kp[18];
  q.rwkv_k_k = (const float*)(const __attribute__((address_space(1))) float*)kp[19];
  q.rwkv_k_a = (const float*)(const __attribute__((address_space(1))) float*)kp[20];
  q.rwkv_r_k = (const float*)(const __attribute__((address_space(1))) float*)kp[21];
  q.rwkv_ln_gain = (const float*)(const __attribute__((address_space(1))) float*)kp[22];
  q.rwkv_ln_bias = (const float*)(const __attribute__((address_space(1))) float*)kp[23];
  q.rwkv_w_out = (const float*)(const __attribute__((address_space(1))) float*)kp[24];
  q.mla_w_in = (const float*)(const __attribute__((address_space(1))) float*)kp[25];
  q.mla_q_norm = (const float*)(const __attribute__((address_space(1))) float*)kp[26];
  q.mla_kv_norm = (const float*)(const __attribute__((address_space(1))) float*)kp[27];
  q.mla_w_uq = (const float*)(const __attribute__((address_space(1))) float*)kp[28];
  q.mla_w_ukv = (const float*)(const __attribute__((address_space(1))) float*)kp[29];
  q.mla_qk_gain_q = (const float*)(const __attribute__((address_space(1))) float*)kp[30];
  q.mla_qk_gain_k = (const float*)(const __attribute__((address_space(1))) float*)kp[31];
  q.mla_w_out = (const float*)(const __attribute__((address_space(1))) float*)kp[32];
  q.out = (float*)(__attribute__((address_space(1))) float*)kp[33];
  q.ws = (char*)(__attribute__((address_space(1))) char*)kp[34];
  return q;
}

#define XB_TMO      128
#define XB_XCNT(j)  (256  + 64 * (j))
#define XB_XSUB(j)  (1280 + 64 * (j))
#define XB_XGEN(j)  (2304 + 64 * (j))
#define XB_TOP      3328
#define XB_TOPGEN   3392
#define XCD_BAR_WORDS 3456
#define XB_SPIN_CAP (1u << 18)
#define LAS __attribute__((address_space(3)))
DI unsigned xb_ld(unsigned* p)              { return __hip_atomic_load(p, __ATOMIC_RELAXED, __HIP_MEMORY_SCOPE_AGENT); }
DI unsigned xb_add(unsigned* p, unsigned v) { return __hip_atomic_fetch_add(p, v, __ATOMIC_RELAXED, __HIP_MEMORY_SCOPE_AGENT); }
DI unsigned xb_xcc_id() { return (unsigned)__builtin_amdgcn_s_getreg((3 << 11) | 20) & 0xFu; }
#define XB_SPIN(cond, bar) do { unsigned _sp = 0; while (cond) { __builtin_amdgcn_s_sleep(1); \
    if ((++_sp & 255u) == 0u) { if (xb_ld(&(bar)[XB_TMO])) break; if (_sp > XB_SPIN_CAP) { atomicAdd(&(bar)[XB_TMO], 1u); break; } } } } while (0)
struct XcdBarrier { unsigned* bar; unsigned x; volatile LAS unsigned* st; };
DI XcdBarrier xcd_barrier_post(unsigned* bar, volatile LAS unsigned* st) {
  XcdBarrier b; b.bar = bar; b.x = xb_xcc_id(); b.st = st;
  if (threadIdx.x == 0) (void)xb_add(&bar[XB_XCNT(b.x)], 1u);
  return b;
}
DI void xcd_barrier_complete(unsigned* bar, unsigned x, unsigned& nloc, unsigned& nx) {
  const unsigned G = gridDim.x * gridDim.y * gridDim.z;
  unsigned sum, cnt, mine, sp = 0u;
  for (;;) {
    sum = 0u; cnt = 0u; mine = 0u;
#pragma unroll
    for (unsigned j = 0; j < 16; ++j) { const unsigned c = xb_ld(&bar[XB_XCNT(j)]); sum += c; cnt += (c > 0u) ? 1u : 0u; mine = (j == x) ? c : mine; }
    if (sum == G) break;
    __builtin_amdgcn_s_sleep(1);
    if ((++sp & 255u) == 0u) { if (xb_ld(&bar[XB_TMO])) break; if (sp > XB_SPIN_CAP) { atomicAdd(&bar[XB_TMO], 1u); break; } }
  }
  nloc = mine > 0u ? mine : 1u; nx = cnt > 0u ? cnt : 1u;
}
DI void xcd_barrier(const XcdBarrier& b) {
  asm volatile("s_waitcnt vmcnt(0)" ::: "memory");
  __syncthreads();
  if (threadIdx.x == 0) {
    unsigned* bar = b.bar;
    __builtin_amdgcn_s_waitcnt(0);
    unsigned nloc = b.st[0], nx = b.st[1];
    if (nloc == 0u) { xcd_barrier_complete(bar, b.x, nloc, nx); b.st[0] = nloc; b.st[1] = nx; }
    const unsigned old = xb_add(&bar[XB_XSUB(b.x)], 1u);
    const unsigned gen = old / nloc;
    if (old + 1u == (gen + 1u) * nloc) {
      __builtin_amdgcn_fence(__ATOMIC_RELEASE, "agent");
      asm volatile("s_waitcnt vmcnt(0)" ::: "memory");
      const unsigned og = xb_add(&bar[XB_TOP], 1u);
      const unsigned tg = og / nx;
      if (og + 1u == (tg + 1u) * nx) xb_add(&bar[XB_TOPGEN], 1u);
      else XB_SPIN(xb_ld(&bar[XB_TOPGEN]) == tg, bar);
      __builtin_amdgcn_fence(__ATOMIC_ACQUIRE, "agent");
      xb_add(&bar[XB_XGEN(b.x)], 1u);
      asm volatile("s_waitcnt vmcnt(0)" ::: "memory");
    } else {
      XB_SPIN(xb_ld(&bar[XB_XGEN(b.x)]) == gen, bar);
      __builtin_amdgcn_fence(__ATOMIC_ACQUIRE, "agent");
      asm volatile("s_waitcnt vmcnt(0)" ::: "memory");
    }
  }
  __syncthreads();
}

#ifndef ONLY_PH
#define ONLY_PH -1
#endif
#ifndef SKIP_PH
#define SKIP_PH -2
#endif
#ifndef SKIP_PH2
#define SKIP_PH2 -2
#endif
#ifndef PROBE
#define PROBE 0
#endif
#define PH(n) ((ONLY_PH < 0 || ONLY_PH == (n)) && SKIP_PH != (n) && SKIP_PH2 != (n))
__global__ void __launch_bounds__(NTHREADS, LB2) mega(Params p) {
  __shared__ __attribute__((aligned(16))) char smem[SMEM_BYTES];
  cg::grid_group grid = cg::this_grid();
  __shared__ uint4 xb_words;
  if (threadIdx.x == 0) xb_words = make_uint4(0u, 0u, 0u, 0u);
  __syncthreads();
  const XcdBarrier xb = xcd_barrier_post((unsigned*)(p.ws + OFF_BAR), (volatile LAS unsigned*)&xb_words);
  if (PH(0)) { const Params q = ldp(); const u16* W = (const u16*)(q.ws + OFF_W); (void)W; phase_prologue(q, smem); }
  if (p.out == nullptr) grid.sync();
  xcd_barrier(xb);
  if (PH(1)) { const Params q = ldp(); const u16* W = (const u16*)(q.ws + OFF_W); (void)W; phase_norm(q, 0, MALL); }
  xcd_barrier(xb);
  if (PROBE & 32) { const Params q = ldp(); phase_sgu_g1_dry(q, MALL, smem); xcd_barrier(xb); }
  if (PH(2)) { const Params q = ldp(); const u16* W = (const u16*)(q.ws + OFF_W); (void)W; phase_sgu_g1(q, 0, MALL, smem); }
  xcd_barrier(xb);
  if (PH(3)) { const Params q = ldp(); const u16* W = (const u16*)(q.ws + OFF_W); (void)W; phase_sgu_mix(q, 0, MALL, smem); }
  xcd_barrier(xb);
  if (PH(4)) { const Params q = ldp(); const u16* W = (const u16*)(q.ws + OFF_W); (void)W; phase_outproj(q, 0, (const u16*)(q.ws + OFF_GUZ), 2048, W + W_SGUOUT, MALL, smem); }
  xcd_barrier(xb);
  if (PH(5)) { const Params q = ldp(); const u16* W = (const u16*)(q.ws + OFF_W); (void)W; phase_norm(q, 1, MALL); }
  xcd_barrier(xb);
  if (PROBE & 4) { const Params q = ldp(); phase_rwkv_g(q, smem); xcd_barrier(xb); }
  if (PH(6)) { const Params q = ldp(); const u16* W = (const u16*)(q.ws + OFF_W); (void)W; phase_rwkv_g(q, smem); }
  xcd_barrier(xb);
  if (PROBE & 2) { const Params q = ldp(); phase_scan_seq(q, smem); xcd_barrier(xb); }
  if (PH(7)) { const Params q = ldp(); phase_scan_seq(q, smem); }
  xcd_barrier(xb);
  if (PH(10)) { const Params q = ldp(); const u16* W = (const u16*)(q.ws + OFF_W); (void)W; phase_rwkv_ln(q); }
  xcd_barrier(xb);
  if (PH(11)) { const Params q = ldp(); const u16* W = (const u16*)(q.ws + OFF_W); (void)W; phase_outproj(q, 1, (const u16*)(q.ws + OFF_Z), 1024, W + W_ROUT, MALL, smem); }
  xcd_barrier(xb);
  if (PH(12)) { const Params q = ldp(); const u16* W = (const u16*)(q.ws + OFF_W); (void)W; phase_norm(q, 2, MALL); }
  xcd_barrier(xb);
  if (PH(13)) { const Params q = ldp(); const u16* W = (const u16*)(q.ws + OFF_W); (void)W; phase_mla_in(q, smem); }
  xcd_barrier(xb);
#pragma unroll 1
  for (int g = 0; g < 4; ++g) {
    if (PROBE & 8) { const Params q = ldp(); phase_mla_up(q, g, smem); xcd_barrier(xb); }
    if (PH(14)) { const Params q = ldp(); const u16* W = (const u16*)(q.ws + OFF_W); (void)W; phase_mla_up(q, g, smem); }
    xcd_barrier(xb);
    if (PROBE & 1) { const Params q = ldp(); phase_attn(q, g, smem, true); xcd_barrier(xb); }
    if (PH(15)) { const Params q = ldp(); const u16* W = (const u16*)(q.ws + OFF_W); (void)W; phase_attn(q, g, smem); }
    xcd_barrier(xb);
  }
  if (PH(22)) { const Params q = ldp(); const u16* W = (const u16*)(q.ws + OFF_W); (void)W; phase_outproj(q, 2, (const u16*)(q.ws + OFF_SZ), 2048, W + W_MOUT, T, smem); }
  xcd_barrier(xb);
  if (PH(23)) { const Params q = ldp(); const u16* W = (const u16*)(q.ws + OFF_W); (void)W; phase_norm(q, 3, T); }
  xcd_barrier(xb);
  if (PH(24)) { const Params q = ldp(); const u16* W = (const u16*)(q.ws + OFF_W); (void)W; phase_sgu_g1(q, 3, T, smem); }
  xcd_barrier(xb);
  if (PH(25)) { const Params q = ldp(); const u16* W = (const u16*)(q.ws + OFF_W); (void)W; phase_sgu_mix(q, 3, T, smem); }
  xcd_barrier(xb);
  if (PH(26)) { const Params q = ldp(); const u16* W = (const u16*)(q.ws + OFF_W); (void)W; phase_outproj(q, 3, (const u16*)(q.ws + OFF_GUZ), 2048, W + W_SGUOUT + 1024ull * 2048, T, smem); }
}

extern "C" void kernel_launch(void* const* d_in, const int* in_sizes, int n_in, void* d_out, int out_size, void* d_ws, size_t ws_size, hipStream_t stream) {
  static int grid_blocks = 0;
  if (!grid_blocks) {
    int dev = 0, cus = 0, per_cu = 0;
    hipGetDevice(&dev);
    hipDeviceGetAttribute(&cus, hipDeviceAttributeMultiprocessorCount, dev);
    hipOccupancyMaxActiveBlocksPerMultiprocessor(&per_cu, mega, NTHREADS, 0);
    if (per_cu > 2) per_cu = 2;
    if (per_cu < 1) per_cu = 1;
    grid_blocks = cus * per_cu;
  }
  Params p{};
  const float** f = (const float**)&p;
  for (int i = 0; i < 33; ++i) f[i] = (const float*)d_in[i];
  p.out = (float*)d_out;
  p.ws = (char*)d_ws;
  hipMemsetAsync((char*)d_ws + OFF_BAR, 0, XCD_BAR_WORDS * 4, stream);
  void* args[] = {&p};
  hipError_t e = hipLaunchCooperativeKernel((void*)mega, dim3(grid_blocks), dim3(NTHREADS), args, 0, stream);
  if (e != hipSuccess) fprintf(stderr, "cooperative launch failed: %s (grid %d)\n", hipGetErrorString(e), grid_blocks);
}
```

```cpp
#include <hip/hip_runtime.h>
#include <hip/hip_cooperative_groups.h>
#include <cstdio>
#include <cstdint>
namespace cg = cooperative_groups;

#define DI __device__ __forceinline__
typedef unsigned short u16;
typedef short bf16x8 __attribute__((ext_vector_type(8)));
typedef float f32x16 __attribute__((ext_vector_type(16)));
typedef float f32x4 __attribute__((ext_vector_type(4)));
typedef float f32x2 __attribute__((ext_vector_type(2)));
typedef unsigned u32x4 __attribute__((ext_vector_type(4)));
typedef unsigned u32x2 __attribute__((ext_vector_type(2)));
typedef _Float16 h16;
typedef _Float16 h16x8 __attribute__((ext_vector_type(8)));
typedef _Float16 h16x4 __attribute__((ext_vector_type(4)));

constexpr int D = 1024, NB = 8, SEQ = 8192, CTXL = 256;
constexpr int T = NB * SEQ;
constexpr int TC = NB * CTXL;
constexpr int MALL = T + TC;
constexpr int SMEM_BYTES = 73728;
constexpr int NTHREADS = 256;
#ifndef LB2
#define LB2 2
#endif

constexpr size_t MB = 1ull << 20;
constexpr size_t OFF_W = 0;
constexpr size_t W_SGUIN = 0;
constexpr size_t W_SGUOUT = W_SGUIN + 2ull * 6144 * 1024;
constexpr size_t W_RIN = W_SGUOUT + 2ull * 1024 * 2048;
constexpr size_t W_L1W = W_RIN + 4ull * 1024 * 1024;
constexpr size_t W_L1A = W_L1W + 128ull * 1024;
constexpr size_t W_ROUT = W_L1A + 128ull * 1024;
constexpr size_t W_MIN = W_ROUT + 1024ull * 1024;
constexpr size_t W_UQ = W_MIN + 3200ull * 1024;
constexpr size_t W_UKV = W_UQ + 3072ull * 768;
constexpr size_t W_MOUT = W_UKV + 4096ull * 256;
constexpr size_t W_L2W = W_MOUT + 1024ull * 2048;
constexpr size_t W_L2A = W_L2W + 2ull * 1024 * 64;
constexpr size_t W_END = W_L2A + 2ull * 1024 * 64;
static_assert(W_END * 2 <= 64 * MB, "weights region");
constexpr size_t OFF_MOD = 64 * MB;
constexpr size_t OFF_CS = OFF_MOD + 512 * 1024;
constexpr size_t OFF_MU16 = OFF_CS + 32 * 1024;
constexpr size_t OFF_BAR = OFF_CS + 48 * 1024;
constexpr size_t OFF_SSQA = OFF_CS + 64 * 1024;
constexpr size_t OFF_SSQB = OFF_SSQA + 512 * 1024;
constexpr size_t OFF_SSQR = OFF_SSQB + 512 * 1024;
constexpr size_t OFF_CTX = 66 * MB;
constexpr size_t OFF_BIG = 76 * MB;
constexpr size_t SZ_ACT = (size_t)MALL * 1024 * 2;
constexpr size_t OFF_H = OFF_BIG;
constexpr size_t OFF_GUZ = OFF_H + SZ_ACT;
constexpr size_t OFF_GVT = OFF_GUZ + 2 * SZ_ACT;
constexpr size_t OFF_R = OFF_H + SZ_ACT;
constexpr size_t OFF_K = OFF_R + SZ_ACT;
constexpr size_t OFF_V = OFF_K + SZ_ACT;
constexpr size_t OFF_Z = OFF_V + SZ_ACT;
constexpr size_t OFF_TW = OFF_Z + SZ_ACT;
constexpr size_t OFF_TA = OFF_TW + (size_t)MALL * 128 * 2;
constexpr size_t OFF_BS = OFF_TA + (size_t)MALL * 128 * 2;
constexpr size_t OFF_SUMM = OFF_BS + (size_t)MALL * 32 * 4;
constexpr size_t OFF_Y1 = OFF_SUMM;
constexpr int NUNIT = NB * 16 * 33;
constexpr size_t RWKV_END = OFF_SUMM + (size_t)NUNIT * 4 * 4096 * 2;
constexpr size_t OFF_CQ = OFF_H + SZ_ACT;
constexpr size_t OFF_CKV = OFF_CQ + (size_t)T * 768 * 2;
constexpr size_t OFF_KR = OFF_CKV + (size_t)MALL * 256 * 2;
constexpr size_t OFF_SZ = OFF_KR + (size_t)MALL * 64 * 4;
constexpr size_t OFF_QX = OFF_SZ + (size_t)T * 2048 * 2;
constexpr size_t OFF_KX = OFF_QX + 16384ull * 16 * 256 * 2;
constexpr size_t OFF_VT = OFF_KX + 2ull * 8448 * 16 * 192 * 2;
constexpr size_t MLA_END = OFF_VT + 2ull * 16 * 128 * 8448 * 2;
constexpr size_t WS_NEED = (RWKV_END > MLA_END ? RWKV_END : MLA_END);
static_assert(WS_NEED <= 1024 * MB, "workspace");
static_assert(OFF_GVT + 2 * SZ_ACT <= 1024 * MB, "workspace sgu");

struct Params {
  const float *x, *c, *ctx, *c_ctx, *ada_w, *ada_b;
  const float *sgu_w_in, *sgu_gain, *sgu_w_s, *sgu_b_s, *sgu_w_out;
  const float *rwkv_mu, *rwkv_w_in, *rwkv_w_lora1, *rwkv_w_lora2, *rwkv_w0, *rwkv_a_lora1, *rwkv_a_lora2, *rwkv_a0;
  const float *rwkv_k_k, *rwkv_k_a, *rwkv_r_k, *rwkv_ln_gain, *rwkv_ln_bias, *rwkv_w_out;
  const float *mla_w_in, *mla_q_norm, *mla_kv_norm, *mla_w_uq, *mla_w_ukv, *mla_qk_gain_q, *mla_qk_gain_k, *mla_w_out;
  float* out;
  char* ws;
};

DI u16 f2bf(float x) { unsigned u = __float_as_uint(x); u += 0x7fffu + ((u >> 16) & 1u); return (u16)(u >> 16); }
typedef __bf16 bf16x2_t __attribute__((ext_vector_type(2)));
DI unsigned pack2bf(float a, float b) { const f32x2 v = (f32x2){a, b}; return __builtin_bit_cast(unsigned, __builtin_convertvector(v, bf16x2_t)); }
DI float bflo(unsigned v) { return __uint_as_float(v << 16); }
DI float bfhi(unsigned v) { return __uint_as_float(v & 0xffff0000u); }
DI float sigmoidf_(float x) { return __builtin_amdgcn_rcpf(1.0f + __builtin_amdgcn_exp2f(-1.4426950408889634f * x)); }
DI float siluf_(float x) { return x * sigmoidf_(x); }
DI float geluf_(float x) { const float u = 0.7978845608028654f * (x + 0.044715f * x * x * x); return x * sigmoidf_(2.0f * u); }
DI int crow(int i, int h) { return (i & 3) + 8 * (i >> 2) + 4 * h; }
DI float wave_sum(float v) {
#pragma unroll
  for (int o = 32; o >= 1; o >>= 1) v += __shfl_xor(v, o);
  return v;
}
#define MFMA(a, b, c) __builtin_amdgcn_mfma_f32_32x32x16_bf16((a), (b), (c), 0, 0, 0)

DI int mod_row(int row) { return row < T ? (row >> 13) : 8; }

constexpr int LROW = 144;
template <int MI, int NI, bool F16 = false, class XL, class EPI>
DI void gemm_tile(const XL& xl, const u16* __restrict__ Wt, int ldw, int K, const EPI& epi, char* smem) {
  constexpr int BN = NI * 32, BM = MI * 128;
  constexpr int WCH = BN * 8 / NTHREADS, XCH = BM * 8 / NTHREADS;
  int tid_ = threadIdx.x; asm volatile("" : "+v"(tid_));
  const int tid = tid_, lane = tid & 63, w = tid >> 6, r = lane & 31, h = lane >> 5;
  char* Xs = smem;
  char* Ws = smem + BM * LROW;
  u32x4 xr[XCH], wr[WCH];
  f32x16 acc[MI][NI];
#pragma unroll
  for (int mi = 0; mi < MI; ++mi)
#pragma unroll
    for (int ni = 0; ni < NI; ++ni)
#pragma unroll
      for (int i = 0; i < 16; ++i) acc[mi][ni][i] = 0.f;
#pragma unroll
  for (int j = 0; j < XCH; ++j) { const int c = tid + NTHREADS * j; xr[j] = xl(c >> 3, (c & 7) * 8); }
#pragma unroll
  for (int j = 0; j < WCH; ++j) { const int c = tid + NTHREADS * j; wr[j] = *(const u32x4*)(Wt + (unsigned)((c >> 3) * ldw + (c & 7) * 8)); }
  for (int k0 = 0; k0 < K; k0 += 64) {
    __syncthreads();
#pragma unroll
    for (int j = 0; j < XCH; ++j) { const int c = tid + NTHREADS * j; *(u32x4*)(Xs + (c >> 3) * LROW + (c & 7) * 16) = xr[j]; }
#pragma unroll
    for (int j = 0; j < WCH; ++j) { const int c = tid + NTHREADS * j; *(u32x4*)(Ws + (c >> 3) * LROW + (c & 7) * 16) = wr[j]; }
    if (k0 + 64 < K) {
#pragma unroll
      for (int j = 0; j < XCH; ++j) { const int c = tid + NTHREADS * j; xr[j] = xl(c >> 3, k0 + 64 + (c & 7) * 8); }
#pragma unroll
      for (int j = 0; j < WCH; ++j) { const int c = tid + NTHREADS * j; wr[j] = *(const u32x4*)(Wt + (unsigned)((c >> 3) * ldw + k0 + 64 + (c & 7) * 8)); }
    }
    __syncthreads();
#pragma unroll
    for (int s = 0; s < 4; ++s) {
      bf16x8 xf[MI];
#pragma unroll
      for (int mi = 0; mi < MI; ++mi) xf[mi] = *(const bf16x8*)(Xs + (32 * (MI * w + mi) + r) * LROW + (16 * s + 8 * h) * 2);
#pragma unroll
      for (int ni = 0; ni < NI; ++ni) {
        const bf16x8 wf = *(const bf16x8*)(Ws + (32 * ni + r) * LROW + (16 * s + 8 * h) * 2);
#pragma unroll
        for (int mi = 0; mi < MI; ++mi) {
          if (F16) acc[mi][ni] = __builtin_amdgcn_mfma_f32_32x32x16_f16(__builtin_bit_cast(h16x8, wf), __builtin_bit_cast(h16x8, xf[mi]), acc[mi][ni], 0, 0, 0);
          else acc[mi][ni] = MFMA(wf, xf[mi], acc[mi][ni]);
        }
        if (NI == 8 && (ni & 3) == 3) __builtin_amdgcn_sched_barrier(0);
      }
    }
  }
#pragma unroll
  for (int mi = 0; mi < MI; ++mi) epi(acc[mi], MI * w + mi, r, h);
}


typedef __attribute__((address_space(3))) void* lds_ptr_t;
typedef const __attribute__((address_space(1))) void* glb_ptr_t;
constexpr int GL_STAGE = 24576;
template <class EPI>
DI void gemm_tile_glds(const u16* __restrict__ X, int ldx, const u16* __restrict__ Wt, int ldw, int K, const EPI& epi, char* smem) {
  int tid_ = threadIdx.x; asm volatile("" : "+v"(tid_));
  const int tid = tid_, lane = tid & 63, w = tid >> 6, r = lane & 31, h = lane >> 5;
  const int cs = (tid & 3) ^ ((tid >> 4) & 3);
  const u16* gx = X + (unsigned)((tid >> 2) * ldx + cs * 8);
  const u16* gw = Wt + (unsigned)((tid >> 2) * ldw + cs * 8);
  char* ldst = smem + tid * 16;
  f32x16 acc[2][4];
#pragma unroll
  for (int mi = 0; mi < 2; ++mi)
#pragma unroll
    for (int ni = 0; ni < 4; ++ni)
#pragma unroll
      for (int i = 0; i < 16; ++i) acc[mi][ni][i] = 0.f;
  const int NK = K >> 5;
  auto issue = [&](int kt) {
    char* d = ldst + (kt % 3) * GL_STAGE;
    const u16* sx = gx + kt * 32; const u16* sw = gw + kt * 32;
#pragma unroll
    for (int i = 0; i < 4; ++i) __builtin_amdgcn_global_load_lds((glb_ptr_t)(sx + (unsigned)(i * 64 * ldx)), (lds_ptr_t)(d + i * 4096), 16, 0, 0);
#pragma unroll
    for (int i = 0; i < 2; ++i) __builtin_amdgcn_global_load_lds((glb_ptr_t)(sw + (unsigned)(i * 64 * ldw)), (lds_ptr_t)(d + 16384 + i * 4096), 16, 0, 0);
  };
  asm volatile("s_waitcnt vmcnt(0)" ::: "memory");
  __builtin_amdgcn_s_barrier();
  asm volatile("" ::: "memory");
  issue(0); issue(1);
  const int swz = (r >> 2) & 3;
  int xo2[2], wo2[2];
#pragma unroll
  for (int s2 = 0; s2 < 2; ++s2) { const int cofs = ((2 * s2 + h) ^ swz) << 4; xo2[s2] = (64 * w + r) * 64 + cofs; wo2[s2] = 16384 + r * 64 + cofs; }
#pragma unroll 1
  for (int kt = 0; kt < NK; ++kt) {
    if (kt + 1 < NK) asm volatile("s_waitcnt vmcnt(6)" ::: "memory"); else asm volatile("s_waitcnt vmcnt(0)" ::: "memory");
    __builtin_amdgcn_s_barrier();
    asm volatile("" ::: "memory");
    if (kt + 2 < NK) issue(kt + 2);
    const char* sb = smem + (kt % 3) * GL_STAGE;
#pragma unroll
    for (int s2 = 0; s2 < 2; ++s2) {
      bf16x8 xf[2];
#pragma unroll
      for (int mi = 0; mi < 2; ++mi) xf[mi] = *(const bf16x8*)(sb + xo2[s2] + mi * 2048);
#pragma unroll
      for (int ni = 0; ni < 4; ++ni) {
        const bf16x8 wf = *(const bf16x8*)(sb + wo2[s2] + ni * 2048);
#pragma unroll
        for (int mi = 0; mi < 2; ++mi) acc[mi][ni] = MFMA(wf, xf[mi], acc[mi][ni]);
      }
    }
    asm volatile("" ::: "memory");
  }
#pragma unroll
  for (int mi = 0; mi < 2; ++mi) epi(acc[mi], 2 * w + mi, r, h);
}

struct XPlain {
  const u16* base; int ld;
  DI u32x4 operator()(int row, int k) const { return *(const u32x4*)(base + (unsigned)(row * ld + k)); }
};

struct Job { const float* src; u16* dst; int K, Nsrc, Ndst, map; const float* scale; int f16; };
constexpr int NJOBS = 21;
DI Job get_job(const Params& p, int j) {
  u16* W = (u16*)(p.ws + OFF_W);
  Job jb; jb.scale = nullptr; jb.map = 0; jb.f16 = 0;
  if (j < 2) { jb.src = p.sgu_w_in + (size_t)j * 1024 * 6144; jb.dst = W + W_SGUIN + (size_t)j * 6144 * 1024; jb.K = 1024; jb.Nsrc = 6144; jb.Ndst = 6144; jb.map = 1; }
  else if (j < 4) { jb.src = p.sgu_w_out + (size_t)(j - 2) * 2048 * 1024; jb.dst = W + W_SGUOUT + (size_t)(j - 2) * 1024 * 2048; jb.K = 2048; jb.Nsrc = 1024; jb.Ndst = 1024; }
  else if (j < 8) { jb.src = p.rwkv_w_in + (size_t)(j - 4) * 1024 * 1024; jb.dst = W + W_RIN + (size_t)(j - 4) * 1024 * 1024; jb.K = 1024; jb.Nsrc = 1024; jb.Ndst = 1024; }
  else if (j < 10) { jb.src = p.rwkv_w_lora1 + (size_t)(j - 8) * 1024 * 64; jb.dst = W + W_L1W + (size_t)(j - 8) * 64 * 1024; jb.K = 1024; jb.Nsrc = 64; jb.Ndst = 64; }
  else if (j < 12) { jb.src = p.rwkv_a_lora1 + (size_t)(j - 10) * 1024 * 64; jb.dst = W + W_L1A + (size_t)(j - 10) * 64 * 1024; jb.K = 1024; jb.Nsrc = 64; jb.Ndst = 64; }
  else if (j == 12) { jb.src = p.rwkv_w_out; jb.dst = W + W_ROUT; jb.K = 1024; jb.Nsrc = 1024; jb.Ndst = 1024; }
  else if (j == 13) { jb.src = p.mla_w_in; jb.dst = W + W_MIN; jb.K = 1024; jb.Nsrc = 3136; jb.Ndst = 3200; jb.map = 2; }
  else if (j == 14) { jb.src = p.mla_w_uq; jb.dst = W + W_UQ; jb.K = 768; jb.Nsrc = 3072; jb.Ndst = 3072; jb.scale = p.mla_q_norm; }
  else if (j == 15) { jb.src = p.mla_w_ukv; jb.dst = W + W_UKV; jb.K = 256; jb.Nsrc = 4096; jb.Ndst = 4096; jb.scale = p.mla_kv_norm; }
  else if (j == 16) { jb.src = p.mla_w_out; jb.dst = W + W_MOUT; jb.K = 2048; jb.Nsrc = 1024; jb.Ndst = 1024; }
  else if (j < 19) { jb.src = p.rwkv_w_lora2 + (size_t)(j - 17) * 64 * 1024; jb.dst = W + W_L2W + (size_t)(j - 17) * 1024 * 64; jb.K = 64; jb.Nsrc = 1024; jb.Ndst = 1024; jb.f16 = 1; }
  else { jb.src = p.rwkv_a_lora2 + (size_t)(j - 19) * 64 * 1024; jb.dst = W + W_L2A + (size_t)(j - 19) * 1024 * 64; jb.K = 64; jb.Nsrc = 1024; jb.Ndst = 1024; jb.f16 = 1; }
  return jb;
}
DI int map_col(int map, int n) {
  if (map == 0) return n;
  if (map == 1) {
    if (n >= 4096) return 2048 + (n - 4096);
    const int nt = n >> 7, j = n & 127, pp = j >> 6, ns = (j >> 5) & 1, cc = j & 31;
    const int ch = nt * 64 + pp * 32 + cc;
    return ns ? 4096 + ch : ch;
  }
  if (n < 1024) return n;
  if (n < 3072) return n + 64;
  if (n < 3136) return n - 2048;
  return -1;
}

DI void phase_prologue(const Params& p, char* smem) {
  const int tid = threadIdx.x;
  for (int item = blockIdx.x; ; item += gridDim.x) {
    if (item < 48) {
      float* cs = (float*)smem;
      for (int i = tid; i < 9 * 1024; i += NTHREADS) { const float v = i < 8192 ? p.c[i] : p.c_ctx[i - 8192]; cs[i] = siluf_(v); }
      __syncthreads();
      const int gi = item * 256 + tid; const int l = gi / 3072, n = gi % 3072;
      const float* wp = p.ada_w + (size_t)l * 1024 * 3072 + n;
      float a[9];
#pragma unroll
      for (int m = 0; m < 9; ++m) a[m] = p.ada_b[l * 3072 + n];
#pragma unroll 32
      for (int k = 0; k < 1024; ++k) { const float wv = wp[(size_t)k * 3072];
#pragma unroll
        for (int m = 0; m < 9; ++m) a[m] += cs[m * 1024 + k] * wv; }
      float* mo = (float*)(p.ws + OFF_MOD);
#pragma unroll
      for (int m = 0; m < 9; ++m) mo[((size_t)l * 9 + m) * 3072 + n] = a[m];
      __syncthreads();
      continue;
    }
    if (item == 48) {
      f32x2* cs = (f32x2*)(p.ws + OFF_CS);
      for (int i = tid; i < 3072; i += NTHREADS) {
        const int pos = i < 2048 ? (i >> 4) : ((i - 2048) >> 4); const int f = i & 15;
        const float invf = exp2f(-(float)f * (13.287712379549449f / 16.0f));
        const float ang = (float)pos * invf; float s, c; sincosf(ang, &s, &c);
        cs[i] = (f32x2){c, s};
      }
      h16* mu16 = (h16*)(p.ws + OFF_MU16);
      for (int i = tid; i < 6 * 1024; i += NTHREADS) mu16[i] = (h16)p.rwkv_mu[i];
      continue;
    }
    int ti = item - 49; int j = 0; Job jb;
    for (; j < NJOBS; ++j) { jb = get_job(p, j); const int nt = (jb.Ndst / 64) * (jb.K / 64); if (ti < nt) break; ti -= nt; }
    if (j >= NJOBS) break;
    const int nkt = jb.K / 64; const int nt = ti / nkt, kt = ti % nkt;
    float* tile = (float*)smem;
#pragma unroll 4
    for (int q = 0; q < 16; ++q) {
      const int kk = (tid >> 6) + 4 * q, nn = tid & 63; const int sc = map_col(jb.map, nt * 64 + nn); const int k = kt * 64 + kk;
      float v = 0.f; if (sc >= 0) { v = jb.src[(size_t)k * jb.Nsrc + sc]; if (jb.scale) v *= jb.scale[k]; }
      tile[nn * 65 + kk] = v;
    }
    __syncthreads();
    { const int nn = tid >> 2, kq = tid & 3; unsigned o[8];
#pragma unroll
      for (int q = 0; q < 8; ++q) { const float a = tile[nn * 65 + kq * 16 + 2 * q], b = tile[nn * 65 + kq * 16 + 2 * q + 1];
        if (jb.f16) { const h16 ha = (h16)a, hb = (h16)b; o[q] = (unsigned)__builtin_bit_cast(u16, ha) | ((unsigned)__builtin_bit_cast(u16, hb) << 16); } else o[q] = pack2bf(a, b); }
      u32x4* dp = (u32x4*)(jb.dst + (size_t)(nt * 64 + nn) * jb.K + kt * 64 + kq * 16);
      dp[0] = (u32x4){o[0], o[1], o[2], o[3]}; dp[1] = (u32x4){o[4], o[5], o[6], o[7]}; }
    __syncthreads();
  }
}

DI void phase_norm(const Params& p, int l, int nrows) {
  const int lane = threadIdx.x & 63, w = threadIdx.x >> 6;
  const float* mo = (const float*)(p.ws + OFF_MOD) + (size_t)l * 9 * 3072;
  u16* H = (u16*)(p.ws + OFF_H);
  float* sa = (float*)(p.ws + OFF_SSQA); float* sb = (float*)(p.ws + OFF_SSQB);
  for (int row = blockIdx.x * 4 + w; row < nrows; row += gridDim.x * 4) {
    const float* xs = row < T ? ((l == 0 ? p.x : p.out) + (size_t)row * D) : ((l == 0 ? p.ctx : (const float*)(p.ws + OFF_CTX)) + (size_t)(row - T) * D);
    f32x4 v[4]; float ss = 0.f;
#pragma unroll
    for (int j = 0; j < 4; ++j) { v[j] = *(const f32x4*)(xs + lane * 4 + 256 * j); ss += v[j][0] * v[j][0] + v[j][1] * v[j][1] + v[j][2] * v[j][2] + v[j][3] * v[j][3]; }
    ss = wave_sum(ss);
    const float rinv = rsqrtf(ss * (1.0f / 1024.0f) + 1e-6f);
    const float* m = mo + (size_t)mod_row(row) * 3072;
#pragma unroll
    for (int j = 0; j < 4; ++j) {
      const int cidx = lane * 4 + 256 * j;
      const f32x4 sh = *(const f32x4*)(m + cidx), sc = *(const f32x4*)(m + 1024 + cidx);
      float o[4];
#pragma unroll
      for (int e = 0; e < 4; ++e) o[e] = v[j][e] * rinv * (1.0f + sc[e]) + sh[e];
      *(u32x2*)(H + (size_t)row * D + cidx) = (u32x2){pack2bf(o[0], o[1]), pack2bf(o[2], o[3])};
    }
    if (lane == 0) { sa[row] = 0.f; sb[row] = 0.f; }
  }
}

DI void stagger(int nsleep) { if (blockIdx.x >= 256) for (int i = 0; i < nsleep; ++i) __builtin_amdgcn_s_sleep(127); }
struct EpiResidual {
  const Params* p; int l, m0, n0;
  DI void operator()(const f32x16 (&acc)[4], int w, int r, int h) const {
    const int row = m0 + 32 * w + r;
    const float* xin; float* xo;
    if (row < T) { xin = (l == 0 ? p->x : p->out) + (size_t)row * D; xo = p->out + (size_t)row * D; }
    else { xin = (l == 0 ? p->ctx : (const float*)(p->ws + OFF_CTX)) + (size_t)(row - T) * D; xo = (float*)(p->ws + OFF_CTX) + (size_t)(row - T) * D; }
    const float* g = (const float*)(p->ws + OFF_MOD) + ((size_t)l * 9 + mod_row(row)) * 3072 + 2048;
#pragma unroll
    for (int hf = 0; hf < 2; ++hf) {
      f32x4 xv[8], gv[8];
#pragma unroll
      for (int j = 0; j < 8; ++j) { const int ni = 2 * hf + (j >> 2), q = j & 3; const int n = n0 + 32 * ni + 8 * q + 4 * h; xv[j] = *(const f32x4*)(xin + n); gv[j] = *(const f32x4*)(g + n); }
#pragma unroll
      for (int j = 0; j < 8; ++j) { const int ni = 2 * hf + (j >> 2), q = j & 3; const int n = n0 + 32 * ni + 8 * q + 4 * h;
        f32x4 o;
#pragma unroll
        for (int e = 0; e < 4; ++e) o[e] = xv[j][e] + gv[j][e] * acc[ni][4 * q + e];
        *(f32x4*)(xo + n) = o; }
    }
  }
};
DI void phase_outproj(const Params& p, int l, const u16* X, int K, const u16* Wt, int nrows, char* smem) {
  const int ntile = (nrows / 256) * 8;
  for (int t = blockIdx.x; t < ntile; t += gridDim.x) {
    const int xcd = t & 7, lg = t >> 3; const int mt = (lg >> 3) * 8 + xcd, nt = lg & 7;
    EpiResidual ep{&p, l, mt * 256, nt * 128};
    gemm_tile_glds(X + (size_t)mt * 256 * K, K, Wt + (size_t)nt * 128 * K, K, K, ep, smem);
  }
}

struct EpiSguUZ {
  u16* guz; int m0, nt;
  DI void operator()(const f32x16 (&acc)[4], int w, int r, int h) const {
    const int row = m0 + 32 * w + r;
#pragma unroll
    for (int pp = 0; pp < 2; ++pp)
#pragma unroll
      for (int q = 0; q < 4; ++q) {
        float o[4];
#pragma unroll
        for (int e = 0; e < 4; ++e) {
          const float u = acc[2 * pp][4 * q + e], z = acc[2 * pp + 1][4 * q + e];
          const float a2 = 1.5957691216057308f * (u + 0.044715f * u * u * u);
          const float e1 = __builtin_amdgcn_exp2f(-1.4426950408889634f * a2), e2 = __builtin_amdgcn_exp2f(-1.4426950408889634f * z);
          const float den = fminf((1.0f + e1) * (1.0f + e2), 3.0e38f);
          o[e] = u * z * __builtin_amdgcn_rcpf(den);
        }
        *(u32x2*)(guz + (size_t)row * 2048 + nt * 64 + 32 * pp + 8 * q + 4 * h) = (u32x2){pack2bf(o[0], o[1]), pack2bf(o[2], o[3])};
      }
  }
};
struct EpiSguV {
  u16* gvt; float* ssq; int m0, c0;
  DI void operator()(const f32x16 (&acc)[4], int w, int r, int h) const {
    const int qrow = 32 * w + r; const int chunk = (m0 + qrow) >> 7; const int qpos = qrow & 127;
    float ss = 0.f;
#pragma unroll
    for (int ni = 0; ni < 4; ++ni)
#pragma unroll
      for (int i = 0; i < 16; ++i) {
        const float g = geluf_(acc[ni][i]); ss += g * g;
        gvt[((size_t)chunk * 2048 + c0 + 32 * ni + crow(i, h)) * 128 + qpos] = f2bf(g);
      }
    ss += __shfl_xor(ss, 32);
    if (h == 0) atomicAdd(ssq + m0 + qrow, ss);
  }
};
struct EpiSguUZ8 {
  EpiSguUZ a, b;
  DI void operator()(const f32x16 (&acc)[8], int w, int r, int h) const {
    a(reinterpret_cast<const f32x16 (&)[4]>(acc[0]), w, r, h);
    __builtin_amdgcn_sched_barrier(0);
    b(reinterpret_cast<const f32x16 (&)[4]>(acc[4]), w, r, h);
  }
};
struct EpiSguV8 {
  EpiSguV a, b;
  DI void operator()(const f32x16 (&acc)[8], int w, int r, int h) const {
    a(reinterpret_cast<const f32x16 (&)[4]>(acc[0]), w, r, h);
    __builtin_amdgcn_sched_barrier(0);
    b(reinterpret_cast<const f32x16 (&)[4]>(acc[4]), w, r, h);
  }
};
DI void phase_sgu_g1(const Params& p, int l, int nrows, char* smem) {
  const u16* H = (const u16*)(p.ws + OFF_H);
  const u16* Wt = (const u16*)(p.ws + OFF_W) + W_SGUIN + (size_t)(l ? 1 : 0) * 6144 * 1024;
  const int ntile = (nrows / 128) * 24;
  for (int t = blockIdx.x; t < ntile; t += gridDim.x) {
    const int mt = t / 24, n2 = t % 24;
    XPlain xl{H + (size_t)mt * 128 * D, D};
    const u16* wp = Wt + (size_t)n2 * 256 * D;
    if (n2 < 16) {
      EpiSguUZ8 ep{EpiSguUZ{(u16*)(p.ws + OFF_GUZ), mt * 128, 2 * n2}, EpiSguUZ{(u16*)(p.ws + OFF_GUZ), mt * 128, 2 * n2 + 1}};
      gemm_tile<1, 8>(xl, wp, D, D, ep, smem);
    } else {
      const int c0 = (n2 - 16) * 256;
      EpiSguV8 ep{EpiSguV{(u16*)(p.ws + OFF_GVT), (float*)(p.ws + OFF_SSQA), mt * 128, c0}, EpiSguV{(u16*)(p.ws + OFF_GVT), (float*)(p.ws + OFF_SSQA), mt * 128, c0 + 128}};
      gemm_tile<1, 8>(xl, wp, D, D, ep, smem);
    }
  }
}
struct EpiNull {
  float* sink;
  DI void operator()(const f32x16 (&acc)[4], int w, int r, int h) const {
    float t = 0.f;
#pragma unroll
    for (int ni = 0; ni < 4; ++ni)
#pragma unroll
      for (int i = 0; i < 16; ++i) t += acc[ni][i];
    if (t == 1.2345e38f) sink[threadIdx.x] = t;
  }
};
DI void phase_sgu_g1_dry(const Params& p, int nrows, char* smem) {
  const u16* H = (const u16*)(p.ws + OFF_H);
  const u16* Wt = (const u16*)(p.ws + OFF_W) + W_SGUIN;
  const int ntile = (nrows / 256) * 48;
  for (int t = blockIdx.x; t < ntile; t += gridDim.x) {
    const int mt = t / 48, nt = t % 48;
    EpiNull ep{(float*)(p.ws + OFF_SSQR)};
    gemm_tile_glds(H + (size_t)mt * 256 * D, D, Wt + (size_t)nt * 128 * D, D, D, ep, smem);
  }
}
struct XSguMix {
  const float* ws_g; const float* rinv;
  DI u32x4 operator()(int row, int k) const {
    const f32x4 a = *(const f32x4*)(ws_g + row * 128 + k), b = *(const f32x4*)(ws_g + row * 128 + k + 4);
    const f32x4 ra = *(const f32x4*)(rinv + k), rb = *(const f32x4*)(rinv + k + 4);
    return (u32x4){pack2bf(a[0] * ra[0], a[1] * ra[1]), pack2bf(a[2] * ra[2], a[3] * ra[3]), pack2bf(b[0] * rb[0], b[1] * rb[1]), pack2bf(b[2] * rb[2], b[3] * rb[3])};
  }
};
struct EpiSguMix {
  u16* guz; const float* gain; const float* bs_g; int m0, c0;
  DI void operator()(const f32x16 (&acc)[4], int w, int r, int h) const {
    const int pp = 32 * w + r; const float bias = bs_g[pp];
    u16* rowp = guz + (size_t)(m0 + pp) * 2048 + c0;
    u32x2 gz[16];
#pragma unroll
    for (int j = 0; j < 16; ++j) gz[j] = *(const u32x2*)(rowp + 32 * (j >> 2) + 8 * (j & 3) + 4 * h);
#pragma unroll
    for (int j = 0; j < 16; ++j) {
      const int ni = j >> 2, q = j & 3; const int n = 32 * ni + 8 * q + 4 * h;
      const f32x4 gn = *(const f32x4*)(gain + c0 + n);
      const float o0 = (acc[ni][4 * q] * gn[0] + bias) * bflo(gz[j][0]), o1 = (acc[ni][4 * q + 1] * gn[1] + bias) * bfhi(gz[j][0]);
      const float o2 = (acc[ni][4 * q + 2] * gn[2] + bias) * bflo(gz[j][1]), o3 = (acc[ni][4 * q + 3] * gn[3] + bias) * bfhi(gz[j][1]);
      *(u32x2*)(rowp + n) = (u32x2){pack2bf(o0, o1), pack2bf(o2, o3)};
    }
  }
};
struct EpiSguMix8 {
  u16* guz; const float* gain; const float* bs_g; int m0, c0;
  DI void operator()(const f32x16 (&acc)[8], int w, int r, int h) const {
    const int pp = 32 * w + r; const float bias = bs_g[pp];
    u16* rowp = guz + (size_t)(m0 + pp) * 2048 + c0;
#pragma unroll
    for (int hf = 0; hf < 2; ++hf) {
      u32x2 gz[16];
#pragma unroll
      for (int j = 0; j < 16; ++j) gz[j] = *(const u32x2*)(rowp + 128 * hf + 32 * (j >> 2) + 8 * (j & 3) + 4 * h);
#pragma unroll
      for (int j = 0; j < 16; ++j) {
        const int ni = 4 * hf + (j >> 2), q = j & 3; const int n = 32 * ni + 8 * q + 4 * h;
        const f32x4 gn = *(const f32x4*)(gain + c0 + n);
        const float o0 = (acc[ni][4 * q] * gn[0] + bias) * bflo(gz[j][0]), o1 = (acc[ni][4 * q + 1] * gn[1] + bias) * bfhi(gz[j][0]);
        const float o2 = (acc[ni][4 * q + 2] * gn[2] + bias) * bflo(gz[j][1]), o3 = (acc[ni][4 * q + 3] * gn[3] + bias) * bfhi(gz[j][1]);
        *(u32x2*)(rowp + n) = (u32x2){pack2bf(o0, o1), pack2bf(o2, o3)};
      }
    }
  }
};
DI void phase_sgu_mix(const Params& p, int l, int nrows, char* smem) {
  const int lj = l ? 1 : 0;
  const float* ssq = (const float*)(p.ws + OFF_SSQA);
  float* rinv = (float*)(smem + 57344);
  const int ntile = (nrows / 128) * 8;
  for (int t = blockIdx.x; t < ntile; t += gridDim.x) {
    const int chunk = t >> 3, g = t & 7;
    __syncthreads();
    if (threadIdx.x < 128) rinv[threadIdx.x] = rsqrtf(ssq[chunk * 128 + threadIdx.x] * (1.0f / 2048.0f) + 1e-6f);
    __syncthreads();
    XSguMix xl{p.sgu_w_s + ((size_t)lj * 8 + g) * 128 * 128, rinv};
    const int c0 = g * 256;
    EpiSguMix8 ep{(u16*)(p.ws + OFF_GUZ), p.sgu_gain + (size_t)lj * 2048, p.sgu_b_s + ((size_t)lj * 8 + g) * 128, chunk * 128, c0};
    gemm_tile<1, 8>(xl, (const u16*)(p.ws + OFF_GVT) + ((size_t)chunk * 2048 + c0) * 128, 128, 128, ep, smem);
  }
}

struct XLerp {
  const u16* H; const float* mu; int m0;
  DI u32x4 operator()(int row, int k) const {
    const int grow = m0 + row;
    int pos, len; if (grow < T) { pos = grow & (SEQ - 1); len = SEQ; } else { pos = (grow - T) & (CTXL - 1); len = CTXL; }
    const u16* hp = H + (size_t)grow * D + k;
    const u32x4 c = *(const u32x4*)hp;
    u32x4 a = (u32x4){0u, 0u, 0u, 0u}, b = (u32x4){0u, 0u, 0u, 0u};
    if (pos > 0) a = *(const u32x4*)(hp - D);
    if (pos < len - 1) b = *(const u32x4*)(hp + D);
    const f32x4 m0v = *(const f32x4*)(mu + k), m1v = *(const f32x4*)(mu + k + 4);
    u32x4 o;
#pragma unroll
    for (int e = 0; e < 4; ++e) {
      const float c0 = bflo(c[e]), c1 = bfhi(c[e]);
      const float x0 = 0.5f * (bflo(a[e]) + bflo(b[e])) - c0, x1 = 0.5f * (bfhi(a[e]) + bfhi(b[e])) - c1;
      const float mu0 = e < 2 ? m0v[2 * e] : m1v[2 * e - 4], mu1 = e < 2 ? m0v[2 * e + 1] : m1v[2 * e - 3];
      o[e] = pack2bf(c0 + x0 * mu0, c1 + x1 * mu1);
    }
    return o;
  }
};
template <int NI>
struct EpiF16 {
  h16* O; int ld, m0, n0; bool tanh_;
  DI void operator()(const f32x16 (&acc)[NI], int w, int r, int h) const {
    h16* rowp = O + (size_t)(m0 + 32 * w + r) * ld + n0;
#pragma unroll
    for (int ni = 0; ni < NI; ++ni)
#pragma unroll
      for (int q = 0; q < 4; ++q) {
        h16x4 o;
#pragma unroll
        for (int e = 0; e < 4; ++e) { float v = acc[ni][4 * q + e]; if (tanh_) v = 2.0f * sigmoidf_(2.0f * v) - 1.0f; o[e] = (h16)v; }
        *(h16x4*)(rowp + 32 * ni + 8 * q + 4 * h) = o;
      }
  }
};
DI void phase_rwkv_g(const Params& p, char* smem) {
  const u16* H = (const u16*)(p.ws + OFF_H);
  const u16* W = (const u16*)(p.ws + OFF_W);
  for (int vb = blockIdx.x; (vb >> 3) < 1188; vb += gridDim.x) {
    const int xcd = vb & 7, lg = vb >> 3;
    if (lg < 1056) {
      const int mt = lg >> 1, jt = xcd + 8 * (lg & 1); const int c = jt >> 2, nt = jt & 3;
      XLerp xl{H, p.rwkv_mu + (size_t)c * 1024, mt * 128};
      EpiF16<8> ep{(h16*)(p.ws + OFF_R + (size_t)c * SZ_ACT), 1024, mt * 128, nt * 256, false};
      gemm_tile<1, 8>(xl, W + W_RIN + (size_t)c * 1024 * 1024 + (size_t)nt * 256 * 1024, 1024, 1024, ep, smem);
    } else {
      const int l2 = lg - 1056; const int mt = (l2 >> 1) * 8 + xcd, which = l2 & 1;
      XLerp xl{H, p.rwkv_mu + (size_t)(4 + which) * 1024, mt * 128};
      EpiF16<4> ep{(h16*)(p.ws + (which ? OFF_TA : OFF_TW)), 128, mt * 128, 0, which == 0};
      gemm_tile<1, 4>(xl, W + (which ? W_L1A : W_L1W), 1024, 1024, ep, smem);
    }
  }
}

DI int unit_row0(int u) { const int ch = u % 33, bh = u / 33, b = bh >> 4; return ch == 0 ? T + b * CTXL : b * SEQ + (ch - 1) * 256; }

template <bool PASS_C>
DI void phase_scan(const Params& p, char* smem) {
  const int tid = threadIdx.x, lane = tid & 63, w = tid >> 6, dir = w & 1;
  const bool isP = !PASS_C && (w >> 1);
  float* lb = (float*)(smem + w * 14336);
  float* kkb = lb, *rb = lb + 512, *wb = lb + 1024, *kab = lb + 1536, *kdb = lb + 2048, *vb = lb + 2560, *yob = lb + 3072;
  const h16* Rg = (const h16*)(p.ws + OFF_R); const h16* Kg = (const h16*)(p.ws + OFF_K); const h16* Vg = (const h16*)(p.ws + OFF_V);
  const h16* TWg = (const h16*)(p.ws + OFF_TW); const h16* TAg = (const h16*)(p.ws + OFF_TA);
  h16* Yg = (h16*)(p.ws + OFF_H);
  float* BSg = (float*)(p.ws + OFF_BS);
  h16* SUM = (h16*)(p.ws + OFF_SUMM);
  for (int up = blockIdx.x; up < (PASS_C ? NUNIT / 2 : NUNIT); up += gridDim.x) {
    const int u = PASS_C ? 2 * up + (w >> 1) : up;
    const int hd = (u / 33) & 15, ch = u % 33;
    const int row0 = unit_row0(u);
    const int col = hd * 64 + lane;
    const h16* W2Tw = (const h16*)((const u16*)(p.ws + OFF_W) + W_L2W) + (size_t)dir * 1024 * 64;
    const h16* W2Ta = (const h16*)((const u16*)(p.ws + OFF_W) + W_L2A) + (size_t)dir * 1024 * 64;
    f32x2 S[32];
#pragma unroll
    for (int q = 0; q < 32; ++q) S[q] = (f32x2){0.f, 0.f};
    if (PASS_C) {
      if (ch != 0) {
        const h16* sp = SUM + ((size_t)(u * 2 + dir) * 2 + 0) * 4096 + lane * 64;
#pragma unroll
        for (int q = 0; q < 8; ++q) { const h16x8 v = *(const h16x8*)(sp + 8 * q);
#pragma unroll
          for (int e = 0; e < 4; ++e) S[4 * q + e] = (f32x2){(float)v[2 * e], (float)v[2 * e + 1]}; }
      }
    } else {
#pragma unroll
      for (int q = 0; q < 32; ++q) { if (isP && lane == 2 * q) S[q][0] = 1.f; if (isP && lane == 2 * q + 1) S[q][1] = 1.f; }
    }
    for (int j = 0; j < 32; ++j) {
      const int sb = dir == 0 ? j : 31 - j;
      {
        const int col16 = lane & 15, quad = lane >> 4, ts = col16 & 7, eh = col16 >> 3;
        int w2off = (hd * 64 + col16) * 64 + 8 * quad; asm volatile("" : "+v"(w2off));
        const int tok = row0 + sb * 8 + (dir == 0 ? ts : 7 - ts);
        h16x8 bw[2], ba[2];
#pragma unroll
        for (int ks = 0; ks < 2; ++ks) { bw[ks] = *(const h16x8*)(TWg + (size_t)tok * 128 + dir * 64 + 32 * ks + 8 * quad); ba[ks] = *(const h16x8*)(TAg + (size_t)tok * 128 + dir * 64 + 32 * ks + 8 * quad); }
        f32x4 cw[4], ca[4];
#pragma unroll
        for (int et = 0; et < 4; ++et) {
          cw[et] = (f32x4){0.f, 0.f, 0.f, 0.f}; ca[et] = (f32x4){0.f, 0.f, 0.f, 0.f};
#pragma unroll
          for (int ks = 0; ks < 2; ++ks) {
            const h16x8 aw = *(const h16x8*)(W2Tw + w2off + et * 1024 + 32 * ks);
            const h16x8 aa = *(const h16x8*)(W2Ta + w2off + et * 1024 + 32 * ks);
            cw[et] = __builtin_amdgcn_mfma_f32_16x16x32_f16(aw, bw[ks], cw[et], 0, 0, 0);
            ca[et] = __builtin_amdgcn_mfma_f32_16x16x32_f16(aa, ba[ks], ca[et], 0, 0, 0);
          }
        }
        float ssq = 0.f, bsum = 0.f;
        f32x4 kkr[2], kdv[2], axv[2], decv[2], rxv[2], vxv[2], yov[2];
#pragma unroll
        for (int t = 0; t < 2; ++t) {
          const int e0 = (2 * eh + t) * 16 + 4 * quad; const int c0 = hd * 64 + e0;
          const f32x4 wl4 = eh ? cw[2 + t] : cw[t], al4 = eh ? ca[2 + t] : ca[t];
          const size_t gi = (size_t)tok * 1024 + c0;
          const h16x4 k4 = *(const h16x4*)(Kg + gi), r4 = *(const h16x4*)(Rg + gi), v4 = *(const h16x4*)(Vg + gi);
          h16x4 y4 = (h16x4){(h16)0.f, (h16)0.f, (h16)0.f, (h16)0.f};
          if (PASS_C) { if (j >= 16) y4 = *(const h16x4*)(Yg + gi); }
          const f32x4 w04 = *(const f32x4*)(p.rwkv_w0 + dir * 1024 + c0), a04 = *(const f32x4*)(p.rwkv_a0 + dir * 1024 + c0);
          const f32x4 kk4 = *(const f32x4*)(p.rwkv_k_k + c0), ka4 = *(const f32x4*)(p.rwkv_k_a + c0), rk4 = *(const f32x4*)(p.rwkv_r_k + c0);
#pragma unroll
          for (int e = 0; e < 4; ++e) {
            const float kx = (float)k4[e], rx = (float)r4[e];
            const float kr = kx * kk4[e]; ssq += kr * kr; kkr[t][e] = kr;
            const float nx = -(wl4[e] + w04[e]); const float sp = fmaxf(nx, 0.f) + __logf(1.0f + __expf(-fabsf(nx)));
            decv[t][e] = __expf(-__expf(-sp - 0.5f));
            const float ax = sigmoidf_(al4[e] + a04[e]); axv[t][e] = ax;
            const float kd = kx * (1.0f + (ax - 1.0f) * ka4[e]); kdv[t][e] = kd;
            bsum += rx * kd * rk4[e]; rxv[t][e] = rx; vxv[t][e] = (float)v4[e]; yov[t][e] = (float)y4[e];
          }
        }
        ssq += __shfl_xor(ssq, 8); ssq += __shfl_xor(ssq, 16); ssq += __shfl_xor(ssq, 32);
        const float rn = rsqrtf(ssq + 1e-12f);
#pragma unroll
        for (int t = 0; t < 2; ++t) {
          const int e0 = (2 * eh + t) * 16 + 4 * quad; const int li = ts * 64 + e0;
          const f32x4 kkn = kkr[t] * rn;
          *(f32x4*)(kkb + li) = kkn; *(f32x4*)(rb + li) = rxv[t]; *(f32x4*)(wb + li) = decv[t]; *(f32x4*)(kab + li) = kkn * axv[t]; *(f32x4*)(kdb + li) = kdv[t]; *(f32x4*)(vb + li) = vxv[t];
          if (PASS_C) *(f32x4*)(yob + li) = yov[t];
        }
        if (PASS_C) {
          bsum += __shfl_xor(bsum, 8); bsum += __shfl_xor(bsum, 16); bsum += __shfl_xor(bsum, 32);
          if (lane < 8) BSg[((size_t)tok * 16 + hd) * 2 + dir] = bsum;
        }
      }
      __builtin_amdgcn_s_waitcnt(0xc07f);
#ifndef NO_STEP
#pragma unroll 1
      for (int s = 0; s < 8; ++s) {
        const f32x4* kk4 = (const f32x4*)(kkb + s * 64);
        f32x2 d0 = (f32x2){0.f, 0.f}, d1 = (f32x2){0.f, 0.f};
#pragma unroll
        for (int q = 0; q < 16; ++q) {
          const f32x4 k4 = kk4[q]; const f32x2 klo = (f32x2){k4[0], k4[1]}, khi = (f32x2){k4[2], k4[3]};
          d0 = __builtin_elementwise_fma(S[2 * q], klo, d0); d1 = __builtin_elementwise_fma(S[2 * q + 1], khi, d1);
          if ((q & 3) == 3) __builtin_amdgcn_sched_barrier(0);
        }
        const float a2 = -((d0[0] + d0[1]) + (d1[0] + d1[1]));
        const float a1 = isP ? 0.f : vb[s * 64 + lane];
        const f32x2 a1v = (f32x2){a1, a1}, a2v = (f32x2){a2, a2};
        const f32x4* w4p = (const f32x4*)(wb + s * 64); const f32x4* ka4p = (const f32x4*)(kab + s * 64);
        const f32x4* kd4p = (const f32x4*)(kdb + s * 64); const f32x4* r4p = (const f32x4*)(rb + s * 64);
        f32x2 y0 = (f32x2){0.f, 0.f}, y1 = (f32x2){0.f, 0.f};
#pragma unroll
        for (int q = 0; q < 16; ++q) {
          const f32x4 w4 = w4p[q], ka4 = ka4p[q], kd4 = kd4p[q];
          const f32x2 wlo = (f32x2){w4[0], w4[1]}, whi = (f32x2){w4[2], w4[3]};
          const f32x2 kalo = (f32x2){ka4[0], ka4[1]}, kahi = (f32x2){ka4[2], ka4[3]};
          const f32x2 kdlo = (f32x2){kd4[0], kd4[1]}, kdhi = (f32x2){kd4[2], kd4[3]};
          f32x2 t0 = a1v * kdlo, t1 = a1v * kdhi;
          t0 = __builtin_elementwise_fma(a2v, kalo, t0); t1 = __builtin_elementwise_fma(a2v, kahi, t1);
          S[2 * q] = __builtin_elementwise_fma(S[2 * q], wlo, t0); S[2 * q + 1] = __builtin_elementwise_fma(S[2 * q + 1], whi, t1);
          if (PASS_C) {
            const f32x4 r4 = r4p[q];
            y0 = __builtin_elementwise_fma(S[2 * q], (f32x2){r4[0], r4[1]}, y0); y1 = __builtin_elementwise_fma(S[2 * q + 1], (f32x2){r4[2], r4[3]}, y1);
          }
          if ((q & 1) == 1) __builtin_amdgcn_sched_barrier(0);
        }
        if (PASS_C) {
          float y = (y0[0] + y0[1]) + (y1[0] + y1[1]);
          const int tok = row0 + sb * 8 + (dir == 0 ? s : 7 - s);
          y += yob[s * 64 + lane];
          Yg[(size_t)tok * 1024 + col] = (h16)y;
        }
      }
#endif
      __syncthreads();
    }
    if (!PASS_C) {
      h16* sp = SUM + ((size_t)(u * 2 + dir) * 2 + (isP ? 1 : 0)) * 4096 + lane * 64;
#pragma unroll
      for (int q = 0; q < 8; ++q) {
        h16x8 sv;
#pragma unroll
        for (int e = 0; e < 4; ++e) { sv[2 * e] = (h16)S[4 * q + e][0]; sv[2 * e + 1] = (h16)S[4 * q + e][1]; }
        *(h16x8*)(sp + 8 * q) = sv;
      }
    }
  }
}


DI float dpp_add(float x, const int ctrl_sel) {
  int xi = __builtin_bit_cast(int, x); int yi;
  if (ctrl_sel == 0) yi = __builtin_amdgcn_mov_dpp(xi, 0xB1, 0xf, 0xf, true);
  else if (ctrl_sel == 1) yi = __builtin_amdgcn_mov_dpp(xi, 0x4E, 0xf, 0xf, true);
  else yi = __builtin_amdgcn_mov_dpp(xi, 0x141, 0xf, 0xf, true);
  return x + __builtin_bit_cast(float, yi);
}
DI float red8(float x) { x = dpp_add(x, 0); x = dpp_add(x, 1); x = dpp_add(x, 2); return x; }

struct ScanPre { h16x8 bw[2], ba[2]; h16x4 k4, r4, v4; };

DI void phase_scan_seq(const Params& p, char* smem) {
  int tid_ = threadIdx.x; asm volatile("" : "+v"(tid_));
  const int tid = tid_, lane = tid & 63, w = tid >> 6;
  float* fb = (float*)smem;
  float* part = fb + 2 * 6144;
  float* partb = part + 128;
  float* ybuf = partb + 128;
  const h16* Rg = (const h16*)(p.ws + OFF_R); const h16* Kg = (const h16*)(p.ws + OFF_K); const h16* Vg = (const h16*)(p.ws + OFF_V);
  const h16* TWg = (const h16*)(p.ws + OFF_TW); const h16* TAg = (const h16*)(p.ws + OFF_TA);
  float* BSg = (float*)(p.ws + OFF_BS);
  const int ts = lane & 15, quad = lane >> 4;
  const int rowl = w * 16 + (lane >> 2), kq = lane & 3;
  constexpr int NST = 528;
  for (int u = blockIdx.x; u < 256; u += gridDim.x) {
    const int chain = u, dir = chain & 1, bh = chain >> 1, b = bh >> 4, hd = bh & 15;
    h16* Yg = (h16*)(p.ws + (dir == 0 ? OFF_H : OFF_Y1));
    const int e0 = 16 * w + 4 * quad;
    const int c0 = hd * 64 + e0;
    h16x8 aw[2], aa[2];
    {
      const h16* W2Tw = (const h16*)((const u16*)(p.ws + OFF_W) + W_L2W) + (size_t)dir * 1024 * 64 + (size_t)(hd * 64 + 16 * w + ts) * 64 + 8 * quad;
      const h16* W2Ta = (const h16*)((const u16*)(p.ws + OFF_W) + W_L2A) + (size_t)dir * 1024 * 64 + (size_t)(hd * 64 + 16 * w + ts) * 64 + 8 * quad;
      aw[0] = *(const h16x8*)W2Tw; aw[1] = *(const h16x8*)(W2Tw + 32); aa[0] = *(const h16x8*)W2Ta; aa[1] = *(const h16x8*)(W2Ta + 32);
    }
    const f32x4 w0c = *(const f32x4*)(p.rwkv_w0 + dir * 1024 + c0), a0c = *(const f32x4*)(p.rwkv_a0 + dir * 1024 + c0);
    const f32x4 kkc = *(const f32x4*)(p.rwkv_k_k + c0), kac = *(const f32x4*)(p.rwkv_k_a + c0), rkc = *(const f32x4*)(p.rwkv_r_k + c0);
    auto stage_row = [&](int st) -> int {
      if (st < 16) return T + b * CTXL + (dir == 0 ? st : 15 - st) * 16;
      const int q = st - 16; return b * SEQ + (dir == 0 ? q : 511 - q) * 16;
    };
    auto pre_load = [&](int st) -> ScanPre {
      ScanPre pr; const int tok = stage_row(st) + (dir == 0 ? ts : 15 - ts);
      const h16* twp = TWg + (size_t)tok * 128 + dir * 64 + 8 * quad; const h16* tap = TAg + (size_t)tok * 128 + dir * 64 + 8 * quad;
      pr.bw[0] = *(const h16x8*)twp; pr.bw[1] = *(const h16x8*)(twp + 32); pr.ba[0] = *(const h16x8*)tap; pr.ba[1] = *(const h16x8*)(tap + 32);
      const size_t gi = (size_t)tok * 1024 + c0;
      pr.k4 = *(const h16x4*)(Kg + gi); pr.r4 = *(const h16x4*)(Rg + gi); pr.v4 = *(const h16x4*)(Vg + gi);
      return pr;
    };
    auto pre_compute = [&](const ScanPre& pr, int buf) {
      f32x4 cw = (f32x4){0.f, 0.f, 0.f, 0.f}, ca = (f32x4){0.f, 0.f, 0.f, 0.f};
#pragma unroll
      for (int ks = 0; ks < 2; ++ks) { cw = __builtin_amdgcn_mfma_f32_16x16x32_f16(aw[ks], pr.bw[ks], cw, 0, 0, 0); ca = __builtin_amdgcn_mfma_f32_16x16x32_f16(aa[ks], pr.ba[ks], ca, 0, 0, 0); }
      float* B = fb + buf * 6144 + ts * 64 + e0;
      f32x4 kkr, rx, vx, dec, kar, kd; float ssq = 0.f, bsum = 0.f;
#pragma unroll
      for (int e = 0; e < 4; ++e) {
        const float wl = cw[e] + w0c[e], al = ca[e] + a0c[e];
        const float kx = (float)pr.k4[e]; rx[e] = (float)pr.r4[e]; vx[e] = (float)pr.v4[e];
        const float kr = kx * kkc[e]; kkr[e] = kr; ssq += kr * kr;
        const float nx = -wl; const float sp = fmaxf(nx, 0.f) + __logf(1.0f + __expf(-fabsf(nx)));
        dec[e] = __expf(-__expf(-sp - 0.5f));
        const float ax = sigmoidf_(al);
        kd[e] = kx * (1.0f + (ax - 1.0f) * kac[e]); kar[e] = kr * ax;
        bsum += rx[e] * kd[e] * rkc[e];
      }
      *(f32x4*)(B) = kkr; *(f32x4*)(B + 1024) = rx; *(f32x4*)(B + 2048) = dec; *(f32x4*)(B + 3072) = kar; *(f32x4*)(B + 4096) = kd; *(f32x4*)(B + 5120) = vx;
      ssq += __shfl_xor(ssq, 16); ssq += __shfl_xor(ssq, 32);
      bsum += __shfl_xor(bsum, 16); bsum += __shfl_xor(bsum, 32);
      if (lane < 16) { part[(buf * 16 + ts) * 4 + w] = ssq; partb[(buf * 16 + ts) * 4 + w] = bsum; }
    };
    f32x2 S[8];
#pragma unroll
    for (int i = 0; i < 8; ++i) S[i] = (f32x2){0.f, 0.f};
    __syncthreads();
    { const ScanPre pr = pre_load(0); pre_compute(pr, 0); }
    __syncthreads();
#pragma unroll 1
    for (int st = 0; st < NST; ++st) {
      const int cur = st & 1;
      ScanPre pr; const bool more = st + 1 < NST;
      if (more) pr = pre_load(st + 1);
      if (tid < 16) {
        const f32x4 pb = *(const f32x4*)(partb + (cur * 16 + tid) * 4);
        const int tok = stage_row(st) + (dir == 0 ? tid : 15 - tid);
        BSg[((size_t)tok * 16 + hd) * 2 + dir] = (pb[0] + pb[1]) + (pb[2] + pb[3]);
      }
      const float* B = fb + cur * 6144;
      float* yb = ybuf + cur * 1024;
#pragma unroll 8
      for (int s = 0; s < 16; ++s) {
        const float* Bs = B + s * 64 + 16 * kq;
        f32x4 kk[4], ww[4], ka[4], kd[4], rr[4];
#pragma unroll
        for (int q = 0; q < 4; ++q) { kk[q] = *(const f32x4*)(Bs + 4 * q); ww[q] = *(const f32x4*)(Bs + 2048 + 4 * q); ka[q] = *(const f32x4*)(Bs + 3072 + 4 * q); kd[q] = *(const f32x4*)(Bs + 4096 + 4 * q); rr[q] = *(const f32x4*)(Bs + 1024 + 4 * q); }
        const f32x4 pr4 = *(const f32x4*)(part + (cur * 16 + s) * 4);
        const float a1 = B[5120 + s * 64 + rowl];
        f32x2 d0 = S[0] * (f32x2){kk[0][0], kk[0][1]}, d1 = S[1] * (f32x2){kk[0][2], kk[0][3]};
#pragma unroll
        for (int q = 1; q < 4; ++q) { d0 = __builtin_elementwise_fma(S[2 * q], (f32x2){kk[q][0], kk[q][1]}, d0); d1 = __builtin_elementwise_fma(S[2 * q + 1], (f32x2){kk[q][2], kk[q][3]}, d1); }
        float x = (d0[0] + d0[1]) + (d1[0] + d1[1]); x = dpp_add(x, 0); x = dpp_add(x, 1);
        const float rn2 = __builtin_amdgcn_rcpf((pr4[0] + pr4[1]) + (pr4[2] + pr4[3]) + 1e-12f);
        const float a2 = -x * rn2;
        const f32x2 a1v = (f32x2){a1, a1}, a2v = (f32x2){a2, a2};
        f32x2 y0 = (f32x2){0.f, 0.f}, y1 = (f32x2){0.f, 0.f};
#pragma unroll
        for (int q = 0; q < 4; ++q) {
          f32x2 t0 = __builtin_elementwise_fma(a2v, (f32x2){ka[q][0], ka[q][1]}, a1v * (f32x2){kd[q][0], kd[q][1]});
          f32x2 t1 = __builtin_elementwise_fma(a2v, (f32x2){ka[q][2], ka[q][3]}, a1v * (f32x2){kd[q][2], kd[q][3]});
          S[2 * q] = __builtin_elementwise_fma(S[2 * q], (f32x2){ww[q][0], ww[q][1]}, t0);
          S[2 * q + 1] = __builtin_elementwise_fma(S[2 * q + 1], (f32x2){ww[q][2], ww[q][3]}, t1);
          y0 = __builtin_elementwise_fma(S[2 * q], (f32x2){rr[q][0], rr[q][1]}, y0);
          y1 = __builtin_elementwise_fma(S[2 * q + 1], (f32x2){rr[q][2], rr[q][3]}, y1);
        }
        float y = (y0[0] + y0[1]) + (y1[0] + y1[1]); y = dpp_add(y, 0); y = dpp_add(y, 1);
        if (kq == 0) yb[s * 64 + rowl] = y;
      }
      if (more) pre_compute(pr, cur ^ 1);
      __syncthreads();
#pragma unroll
      for (int hh = 0; hh < 4; ++hh) { const int s = (tid >> 6) + 4 * hh, vl = tid & 63; const int tok = stage_row(st) + (dir == 0 ? s : 15 - s);
        Yg[(size_t)tok * 1024 + hd * 64 + vl] = (h16)yb[s * 64 + vl]; }
    }
    __syncthreads();
  }
}

DI void phase_combine(const Params& p, char* smem) {
  const int tid = threadIdx.x, v = tid >> 2, kq = tid & 3;
  float* curs = (float*)smem;
  float* Ps = (float*)(smem + 64 * 68 * 4);
  h16* SUM = (h16*)(p.ws + OFF_SUMM);
  for (int cidx = blockIdx.x; cidx < 256; cidx += gridDim.x) {
    const int dir = cidx & 1, bh = cidx >> 1;
    float cur[16];
#pragma unroll
    for (int e = 0; e < 16; ++e) cur[e] = 0.f;
    for (int i = 0; i < 33; ++i) {
      const int ch = i == 0 ? 0 : (dir == 0 ? i : 33 - i);
      const int u = bh * 33 + ch;
      h16* sp = SUM + ((size_t)(u * 2 + dir) * 2) * 4096;
      const h16x8 se0 = *(const h16x8*)(sp + v * 64 + kq * 16), se1 = *(const h16x8*)(sp + v * 64 + kq * 16 + 8);
      const h16x8 pe0 = *(const h16x8*)(sp + 4096 + v * 64 + kq * 16), pe1 = *(const h16x8*)(sp + 4096 + v * 64 + kq * 16 + 8);
      __syncthreads();
      h16x8 c0, c1;
#pragma unroll
      for (int e = 0; e < 8; ++e) { c0[e] = (h16)cur[e]; c1[e] = (h16)cur[8 + e]; curs[v * 68 + kq * 16 + e] = cur[e]; curs[v * 68 + kq * 16 + 8 + e] = cur[8 + e];
        Ps[v * 64 + kq * 16 + e] = (float)pe0[e]; Ps[v * 64 + kq * 16 + 8 + e] = (float)pe1[e]; }
      *(h16x8*)(sp + v * 64 + kq * 16) = c0; *(h16x8*)(sp + v * 64 + kq * 16 + 8) = c1;
      __syncthreads();
      float nw[16];
#pragma unroll
      for (int e = 0; e < 8; ++e) { nw[e] = (float)se0[e]; nw[8 + e] = (float)se1[e]; }
      for (int jj = 0; jj < 64; jj += 4) {
        const f32x4 cv = *(const f32x4*)(curs + v * 68 + jj);
#pragma unroll
        for (int e4 = 0; e4 < 4; ++e4) {
          const float cs = cv[e4];
#pragma unroll
          for (int q = 0; q < 4; ++q) { const f32x4 pv = *(const f32x4*)(Ps + (jj + e4) * 64 + kq * 16 + 4 * q);
#pragma unroll
            for (int e = 0; e < 4; ++e) nw[4 * q + e] += cs * pv[e]; }
        }
      }
#pragma unroll
      for (int e = 0; e < 16; ++e) cur[e] = nw[e];
    }
    __syncthreads();
  }
}

DI void phase_rwkv_ln(const Params& p) {
  const int lane = threadIdx.x & 63, w = threadIdx.x >> 6, hd = lane >> 2;
  const h16* Yg = (const h16*)(p.ws + OFF_H); const h16* Y1g = (const h16*)(p.ws + OFF_Y1); const h16* Vg = (const h16*)(p.ws + OFF_V);
  h16* Zg = (h16*)(p.ws + OFF_Z); const float* BSg = (const float*)(p.ws + OFF_BS);
  const int c0 = lane * 16;
  for (int row = blockIdx.x * 4 + w; row < MALL; row += gridDim.x * 4) {
    const size_t gi = (size_t)row * 1024 + c0;
    float y[16], vv[16], zz[16];
#pragma unroll
    for (int q = 0; q < 2; ++q) { const h16x8 a = *(const h16x8*)(Yg + gi + 8 * q), a1 = *(const h16x8*)(Y1g + gi + 8 * q), b = *(const h16x8*)(Vg + gi + 8 * q), c = *(const h16x8*)(Zg + gi + 8 * q);
#pragma unroll
      for (int e = 0; e < 8; ++e) { y[8 * q + e] = (float)a[e] + (float)a1[e]; vv[8 * q + e] = (float)b[e]; zz[8 * q + e] = (float)c[e]; } }
    float s = 0.f;
#pragma unroll
    for (int e = 0; e < 16; ++e) s += y[e];
    s += __shfl_xor(s, 1); s += __shfl_xor(s, 2);
    const float mean = s * (1.0f / 64.0f);
    float q2 = 0.f;
#pragma unroll
    for (int e = 0; e < 16; ++e) { const float d = y[e] - mean; q2 += d * d; }
    q2 += __shfl_xor(q2, 1); q2 += __shfl_xor(q2, 2);
    const float rstd = rsqrtf(q2 * (1.0f / 64.0f) + 64e-5f);
    const float bon = BSg[((size_t)row * 16 + hd) * 2] + BSg[((size_t)row * 16 + hd) * 2 + 1];
    unsigned o[8];
#pragma unroll
    for (int e = 0; e < 8; ++e) {
      float t0 = (y[2 * e] - mean) * rstd * p.rwkv_ln_gain[c0 + 2 * e] + p.rwkv_ln_bias[c0 + 2 * e] + bon * vv[2 * e];
      float t1 = (y[2 * e + 1] - mean) * rstd * p.rwkv_ln_gain[c0 + 2 * e + 1] + p.rwkv_ln_bias[c0 + 2 * e + 1] + bon * vv[2 * e + 1];
      o[e] = pack2bf(t0 * siluf_(zz[2 * e]), t1 * siluf_(zz[2 * e + 1]));
    }
    u32x4* op = (u32x4*)(Zg + gi);
    op[0] = (u32x4){o[0], o[1], o[2], o[3]}; op[1] = (u32x4){o[4], o[5], o[6], o[7]};
  }
}

struct EpiMlaIn {
  const Params* p; int m0, nt;
  DI void operator()(const f32x16 (&acc)[4], int w, int r, int h) const {
    const int row = m0 + 32 * w + r;
    if (nt < 8) {
      float ss = 0.f;
      u16* O = nt < 6 ? (u16*)(p->ws + OFF_CQ) + (size_t)row * 768 + nt * 128 : (u16*)(p->ws + OFF_CKV) + (size_t)row * 256 + (nt - 6) * 128;
#pragma unroll
      for (int ni = 0; ni < 4; ++ni)
#pragma unroll
        for (int q = 0; q < 4; ++q) {
          const float a0 = acc[ni][4 * q], a1 = acc[ni][4 * q + 1], a2 = acc[ni][4 * q + 2], a3 = acc[ni][4 * q + 3];
          ss += a0 * a0 + a1 * a1 + a2 * a2 + a3 * a3;
          *(u32x2*)(O + 32 * ni + 8 * q + 4 * h) = (u32x2){pack2bf(a0, a1), pack2bf(a2, a3)};
        }
      ss += __shfl_xor(ss, 32);
      if (h == 0) atomicAdd((float*)(p->ws + (nt < 6 ? OFF_SSQA : OFF_SSQB)) + row, ss);
    } else if (nt < 24) {
      u16* O = (u16*)(p->ws + OFF_SZ) + (size_t)row * 2048 + (nt - 8) * 128;
#pragma unroll
      for (int ni = 0; ni < 4; ++ni)
#pragma unroll
        for (int q = 0; q < 4; ++q)
          *(u32x2*)(O + 32 * ni + 8 * q + 4 * h) = (u32x2){pack2bf(siluf_(acc[ni][4 * q]), siluf_(acc[ni][4 * q + 1])), pack2bf(siluf_(acc[ni][4 * q + 2]), siluf_(acc[ni][4 * q + 3]))};
    } else {
      float* O = (float*)(p->ws + OFF_KR) + (size_t)row * 64; float ss = 0.f;
#pragma unroll
      for (int ni = 0; ni < 2; ++ni)
#pragma unroll
        for (int q = 0; q < 4; ++q) {
          f32x4 o;
#pragma unroll
          for (int e = 0; e < 4; ++e) { o[e] = acc[ni][4 * q + e]; ss += o[e] * o[e]; }
          *(f32x4*)(O + 32 * ni + 8 * q + 4 * h) = o;
        }
      ss += __shfl_xor(ss, 32);
      if (h == 0) ((float*)(p->ws + OFF_SSQR))[row] = ss;
    }
  }
};
DI void phase_mla_in(const Params& p, char* smem) {
  const u16* H = (const u16*)(p.ws + OFF_H);
  const u16* Wt = (const u16*)(p.ws + OFF_W) + W_MIN;
  for (int vb = blockIdx.x; (vb >> 3) < 803; vb += gridDim.x) {
    const int xcd = vb & 7, lg = vb >> 3;
    int mt, nt;
    if (lg < 768) { mt = lg / 3; nt = xcd + 8 * (lg % 3); }
    else if (lg < 800) { mt = (lg - 768) * 8 + xcd; nt = 24; }
    else { const int q = (lg - 800) * 8 + xcd; mt = 256 + q / 3; const int s = q % 3; nt = s == 0 ? 6 : (s == 1 ? 7 : 24); }
    EpiMlaIn ep{&p, mt * 256, nt};
    gemm_tile_glds(H + (size_t)mt * 256 * D, D, Wt + (size_t)nt * 128 * D, D, D, ep, smem);
  }
}

constexpr float QSCALE = 0.07216878364870322f * 1.4426950408889634f;
struct EpiMlaQ {
  const Params* p; int grow0  , lrow0  , head;
  DI void operator()(const f32x16 (&acc)[6], int w, int r, int h) const {
    const int row = grow0 + 32 * w + r, lrow = lrow0 + 32 * w + r;
    const float rq = rsqrtf(((const float*)(p->ws + OFF_SSQA))[row] * (1.0f / 768.0f) + 1e-6f);
    float ss = 0.f;
#pragma unroll
    for (int ni = 0; ni < 6; ++ni)
#pragma unroll
      for (int i = 0; i < 16; ++i) { const float v = acc[ni][i] * rq; ss += v * v; }
    ss += __shfl_xor(ss, 32);
    const float sc = rq * rsqrtf(ss * (1.0f / 192.0f) + 1e-6f) * QSCALE;
    const float* gq = p->mla_qk_gain_q;
    u16* O = (u16*)(p->ws + OFF_QX) + ((size_t)lrow * 16 + head) * 256;
#pragma unroll
    for (int ni = 0; ni < 4; ++ni)
#pragma unroll
      for (int q = 0; q < 4; ++q) {
        const int n = 32 * ni + 8 * q + 4 * h; const f32x4 g = *(const f32x4*)(gq + n);
        *(u32x2*)(O + n) = (u32x2){pack2bf(acc[ni][4 * q] * sc * g[0], acc[ni][4 * q + 1] * sc * g[1]), pack2bf(acc[ni][4 * q + 2] * sc * g[2], acc[ni][4 * q + 3] * sc * g[3])};
      }
    const int pos = row & (SEQ - 1); const int prow = pos >> 6, pcol = pos & 63;
    const f32x2* cs = (const f32x2*)(p->ws + OFF_CS);
#pragma unroll
    for (int q = 0; q < 4; ++q) {
      const int pb = 8 * q + 4 * h;
      float x1[4], x2[4], o1[4], o2[4];
#pragma unroll
      for (int e = 0; e < 4; ++e) {
        const int pi = pb + e;
        x1[e] = acc[4][4 * q + e] * sc * gq[128 + pi]; x2[e] = acc[5][4 * q + e] * sc * gq[160 + pi];
        const f32x2 c = pi < 16 ? cs[prow * 16 + pi] : cs[2048 + pcol * 16 + (pi - 16)];
        o1[e] = x1[e] * c[0] - x2[e] * c[1]; o2[e] = x1[e] * c[1] + x2[e] * c[0];
      }
      *(u32x2*)(O + 128 + pb) = (u32x2){pack2bf(o1[0], o1[1]), pack2bf(o1[2], o1[3])};
      *(u32x2*)(O + 160 + pb) = (u32x2){pack2bf(o2[0], o2[1]), pack2bf(o2[2], o2[3])};
      *(u32x2*)(O + 192 + pb) = (u32x2){pack2bf(x1[0], x1[1]), pack2bf(x1[2], x1[3])};
      *(u32x2*)(O + 224 + pb) = (u32x2){pack2bf(x2[0], x2[1]), pack2bf(x2[2], x2[3])};
    }
  }
};
struct EpiMlaKV {
  const Params* p; int grow0, kvrow0  , head, isv, blocal;
  DI void operator()(const f32x16 (&acc)[4], int w, int r, int h) const {
    const int row = grow0 + 32 * w + r, kvrow = kvrow0 + 32 * w + r;
    const float rkv = rsqrtf(((const float*)(p->ws + OFF_SSQB))[row] * (1.0f / 256.0f) + 1e-6f);
    if (isv) {
      u16* O = (u16*)(p->ws + OFF_VT) + ((size_t)(blocal * 16 + head) * 128) * 8448 + (kvrow - blocal * 8448);
#pragma unroll
      for (int ni = 0; ni < 4; ++ni)
#pragma unroll
        for (int i = 0; i < 16; ++i) O[(size_t)(32 * ni + crow(i, h)) * 8448] = f2bf(acc[ni][i] * rkv);
      return;
    }
    float ss = 0.f;
#pragma unroll
    for (int ni = 0; ni < 4; ++ni)
#pragma unroll
      for (int i = 0; i < 16; ++i) { const float v = acc[ni][i] * rkv; ss += v * v; }
    ss += __shfl_xor(ss, 32);
    ss += ((const float*)(p->ws + OFF_SSQR))[row];
    const float rn = rsqrtf(ss * (1.0f / 192.0f) + 1e-6f); const float sc = rkv * rn;
    const float* gk = p->mla_qk_gain_k;
    u16* O = (u16*)(p->ws + OFF_KX) + ((size_t)kvrow * 16 + head) * 192;
#pragma unroll
    for (int ni = 0; ni < 4; ++ni)
#pragma unroll
      for (int q = 0; q < 4; ++q) {
        const int n = 32 * ni + 8 * q + 4 * h; const f32x4 g = *(const f32x4*)(gk + n);
        *(u32x2*)(O + n) = (u32x2){pack2bf(acc[ni][4 * q] * sc * g[0], acc[ni][4 * q + 1] * sc * g[1]), pack2bf(acc[ni][4 * q + 2] * sc * g[2], acc[ni][4 * q + 3] * sc * g[3])};
      }
    const float* kr = (const float*)(p->ws + OFF_KR) + (size_t)row * 64;
    const bool lat = row < T; const int pos = row & (SEQ - 1);
    const f32x2* cs = (const f32x2*)(p->ws + OFF_CS) + (h == 0 ? (pos >> 6) * 16 : 2048 + (pos & 63) * 16);
    unsigned o1[8], o2[8];
#pragma unroll
    for (int e = 0; e < 8; ++e) {
      float a[2], b[2];
#pragma unroll
      for (int t = 0; t < 2; ++t) {
        const int pi = 16 * h + 2 * e + t;
        const float x1 = kr[pi] * rn * gk[128 + pi], x2 = kr[32 + pi] * rn * gk[160 + pi];
        f32x2 c = (f32x2){1.f, 0.f}; if (lat) c = cs[2 * e + t];
        a[t] = x1 * c[0] - x2 * c[1]; b[t] = x1 * c[1] + x2 * c[0];
      }
      o1[e] = pack2bf(a[0], a[1]); o2[e] = pack2bf(b[0], b[1]);
    }
    u32x4* d1 = (u32x4*)(O + 128 + 16 * h); u32x4* d2 = (u32x4*)(O + 160 + 16 * h);
    d1[0] = (u32x4){o1[0], o1[1], o1[2], o1[3]}; d1[1] = (u32x4){o1[4], o1[5], o1[6], o1[7]};
    d2[0] = (u32x4){o2[0], o2[1], o2[2], o2[3]}; d2[1] = (u32x4){o2[4], o2[5], o2[6], o2[7]};
  }
};
struct EpiMlaKV8 {
  EpiMlaKV k, v;
  DI void operator()(const f32x16 (&acc)[8], int w, int r, int h) const {
    v(reinterpret_cast<const f32x16 (&)[4]>(acc[4]), w, r, h);
    __builtin_amdgcn_sched_barrier(0);
    k(reinterpret_cast<const f32x16 (&)[4]>(acc[0]), w, r, h);
  }
};
DI void phase_mla_up(const Params& p, int g, char* smem) {
  const u16* W = (const u16*)(p.ws + OFF_W);
  const int nq = 128 * 16, nkv = 132 * 16;
  for (int t = blockIdx.x; t < nq + nkv; t += gridDim.x) {
    if (t < nq) {
      const int mt = t >> 4, head = t & 15;
      const int grow0 = g * 16384 + mt * 128;
      XPlain xl{(const u16*)(p.ws + OFF_CQ) + (size_t)grow0 * 768, 768};
      EpiMlaQ ep{&p, grow0, mt * 128, head};
      gemm_tile<1, 6>(xl, W + W_UQ + (size_t)head * 192 * 768, 768, 768, ep, smem);
    } else {
      const int q = t - nq; const int mt = q >> 4, head = q & 15;
      int grow0, kvrow0, blocal;
      if (mt < 128) { blocal = mt >> 6; grow0 = g * 16384 + mt * 128; kvrow0 = blocal * 8448 + 256 + (mt & 63) * 128; }
      else { const int cm = mt - 128; blocal = cm >> 1; grow0 = T + (g * 2 + blocal) * 256 + (cm & 1) * 128; kvrow0 = blocal * 8448 + (cm & 1) * 128; }
      XPlain xl{(const u16*)(p.ws + OFF_CKV) + (size_t)grow0 * 256, 256};
      EpiMlaKV8 ep{EpiMlaKV{&p, grow0, kvrow0, head, 0, blocal}, EpiMlaKV{&p, grow0, kvrow0, head, 1, blocal}};
      gemm_tile<1, 8>(xl, W + W_UKV + (size_t)head * 256 * 256, 256, 256, ep, smem);
    }
  }
}

DI int kswap(int r) { return (r & ~12) | ((r & 4) << 1) | ((r & 8) >> 1); }
constexpr int KROW = 400;
DI void phase_attn(const Params& p, int g, char* smem, bool dry = false) {
  int tid_ = threadIdx.x; asm volatile("" : "+v"(tid_));
  const int tid = tid_, lane = tid & 63, w = tid >> 6, r = lane & 31, h = lane >> 5;
  char* Ks = smem; char* Vs = smem + 64 * KROW;
  const u16* QX = (const u16*)(p.ws + OFF_QX); const u16* KX = (const u16*)(p.ws + OFF_KX); const u16* VT = (const u16*)(p.ws + OFF_VT);
  u16* SZ = (u16*)(p.ws + OFF_SZ);
  const int ksr = kswap(r);
  for (int uu = blockIdx.x; uu < 2048; uu += gridDim.x) {
    const int xcd = uu & 7, lg = uu >> 3; const int bh = (lg >> 6) * 8 + xcd;
    const int qb = lg & 63, head = bh & 15, blocal = bh >> 4;
    const int lq = blocal * 8192 + qb * 128 + 32 * w + r;
    const u16* qp = QX + ((size_t)lq * 16 + head) * 256;
    bf16x8 qf[12];
#pragma unroll
    for (int ds = 0; ds < 8; ++ds) qf[ds] = *(const bf16x8*)(qp + 16 * ds + 8 * h);
#pragma unroll
    for (int ds = 0; ds < 4; ++ds) qf[8 + ds] = *(const bf16x8*)(qp + 192 + 16 * ds + 8 * h);
    f32x16 O[4];
#pragma unroll
    for (int di = 0; di < 4; ++di)
#pragma unroll
      for (int i = 0; i < 16; ++i) O[di][i] = 0.f;
    float m = -1e30f, l = 0.f;
    const u16* kbase = KX + ((size_t)blocal * 8448 * 16 + head) * 192;
    const u16* vbase = VT + (size_t)(blocal * 16 + head) * 128 * 8448;
    u32x4 kr_[6], vr_[4];
    const u16* kptr = kbase + (size_t)(tid >> 2) * 3072 + (tid & 3) * 8;
    const u16* vptr = vbase + (size_t)(tid >> 1) * 8448 + (tid & 1) * 32;
    char* kls = Ks + (tid >> 2) * KROW + (tid & 3) * 16;
    char* vls = Vs + (tid >> 1) * LROW + (tid & 1) * 64;
#pragma unroll
    for (int j = 0; j < 6; ++j) kr_[j] = *(const u32x4*)(kptr + 32 * j);
#pragma unroll
    for (int j = 0; j < 4; ++j) vr_[j] = *(const u32x4*)(vptr + 8 * j);
#pragma unroll 1
    for (int kt = 0; kt < 132; ++kt) {
      __syncthreads();
#pragma unroll
      for (int j = 0; j < 6; ++j) *(u32x4*)(kls + 64 * j) = kr_[j];
#pragma unroll
      for (int j = 0; j < 4; ++j) *(u32x4*)(vls + 16 * j) = vr_[j];
      __syncthreads();
      if (kt + 1 < 132) {
        kptr += 64 * 3072; vptr += 64;
#pragma unroll
        for (int j = 0; j < 6; ++j) kr_[j] = *(const u32x4*)(kptr + 32 * j);
#pragma unroll
        for (int j = 0; j < 4; ++j) vr_[j] = *(const u32x4*)(vptr + 8 * j);
      }
      if (kt == 4) {
#pragma unroll
        for (int ds = 0; ds < 4; ++ds) qf[8 + ds] = *(const bf16x8*)(qp + 128 + 16 * ds + 8 * h);
      }
      f32x16 St[2];
      __builtin_amdgcn_s_setprio(1);
#pragma unroll
      for (int kb = 0; kb < 2; ++kb) {
#pragma unroll
        for (int i = 0; i < 16; ++i) St[kb][i] = 0.f;
#pragma unroll
        for (int ds = 0; ds < 12; ++ds) {
          const bf16x8 kf = *(const bf16x8*)(Ks + (32 * kb + ksr) * KROW + (16 * ds + 8 * h) * 2);
          St[kb] = MFMA(kf, qf[ds], St[kb]);
          if ((ds & 3) == 3) __builtin_amdgcn_sched_barrier(0);
        }
      }
      __builtin_amdgcn_s_setprio(0);
      asm volatile("s_nop 7\n\ts_nop 7" ::: "memory");
      float mx = St[0][0];
#pragma unroll
      for (int kb = 0; kb < 2; ++kb)
#pragma unroll
        for (int i = 0; i < 16; ++i) mx = fmaxf(mx, St[kb][i]);
      mx = fmaxf(mx, __shfl_xor(mx, 32));
      const float mn = fmaxf(m, mx); const float alpha = __builtin_amdgcn_exp2f(m - mn); m = mn;
      St[0] = St[0] - mn; St[1] = St[1] - mn;
#pragma unroll
      for (int kb = 0; kb < 2; ++kb)
#pragma unroll
        for (int i = 0; i < 16; ++i) St[kb][i] = __builtin_amdgcn_exp2f(St[kb][i]);
      float ls;
      { const f32x16 t = St[0] + St[1];
        const f32x4 a = (f32x4){t[0], t[1], t[2], t[3]} + (f32x4){t[4], t[5], t[6], t[7]} + (f32x4){t[8], t[9], t[10], t[11]} + (f32x4){t[12], t[13], t[14], t[15]};
        ls = (a[0] + a[1]) + (a[2] + a[3]); }
      l = l * alpha + ls;
      if (__builtin_amdgcn_ballot_w64(alpha != 1.0f) != 0ull) {
#pragma unroll
        for (int di = 0; di < 4; ++di)
#pragma unroll
          for (int i = 0; i < 16; ++i) O[di][i] *= alpha;
      }
      __builtin_amdgcn_s_setprio(1);
#pragma unroll
      for (int kb = 0; kb < 2; ++kb)
#pragma unroll
        for (int s = 0; s < 2; ++s) {
          u32x4 pk;
#pragma unroll
          for (int e = 0; e < 4; ++e) pk[e] = pack2bf(St[kb][8 * s + 2 * e], St[kb][8 * s + 2 * e + 1]);
          const bf16x8 pf = __builtin_bit_cast(bf16x8, pk);
#pragma unroll
          for (int di = 0; di < 4; ++di) {
            const bf16x8 vf = *(const bf16x8*)(Vs + (32 * di + r) * LROW + (32 * kb + 16 * s + 8 * h) * 2);
            O[di] = MFMA(vf, pf, O[di]);
          }
          __builtin_amdgcn_sched_barrier(0);
        }
      __builtin_amdgcn_s_setprio(0);
      asm volatile("s_nop 7\n\ts_nop 7" ::: "memory");
    }
    l += __shfl_xor(l, 32);
    const float inv = 1.0f / l;
    const int grow = g * 16384 + lq;
    u16* op = SZ + (size_t)grow * 2048 + head * 128;
    if (dry && l > 0.f) continue;
#pragma unroll
    for (int di = 0; di < 4; ++di)
#pragma unroll
      for (int q = 0; q < 4; ++q) {
        const int n = 32 * di + 8 * q + 4 * h;
        const u32x2 z = *(const u32x2*)(op + n);
        *(u32x2*)(op + n) = (u32x2){pack2bf(O[di][4 * q] * inv * bflo(z[0]), O[di][4 * q + 1] * inv * bfhi(z[0])), pack2bf(O[di][4 * q + 2] * inv * bflo(z[1]), O[di][4 * q + 3] * inv * bfhi(z[1]))};
      }
  }
}

typedef const volatile __attribute__((address_space(4))) unsigned long long* kargp_t;
DI Params ldp() {
  kargp_t kp = (kargp_t)__builtin_amdgcn_kernarg_segment_ptr();
  Params q;
  q.x = (const float*)(const __attribute__((address_space(1))) float*)kp[0];
  q.c = (const float*)(const __attribute__((address_space(1))) float*)kp[1];
  q.ctx = (const float*)(const __attribute__((address_space(1))) float*)kp[2];
  q.c_ctx = (const float*)(const __attribute__((address_space(1))) float*)kp[3];
  q.ada_w = (const float*)(const __attribute__((address_space(1))) float*)kp[4];
  q.ada_b = (const float*)(const __attribute__((address_space(1))) float*)kp[5];
  q.sgu_w_in = (const float*)(const __attribute__((address_space(1))) float*)kp[6];
  q.sgu_gain = (const float*)(const __attribute__((address_space(1))) float*)kp[7];
  q.sgu_w_s = (const float*)(const __attribute__((address_space(1))) float*)kp[8];
  q.sgu_b_s = (const float*)(const __attribute__((address_space(1))) float*)kp[9];
  q.sgu_w_out = (const float*)(const __attribute__((address_space(1))) float*)kp[10];
  q.rwkv_mu = (const float*)(const __attribute__((address_space(1))) float*)kp[11];
  q.rwkv_w_in = (const float*)(const __attribute__((address_space(1))) float*)kp[12];
  q.rwkv_w_lora1 = (const float*)(const __attribute__((address_space(1))) float*)kp[13];
  q.rwkv_w_lora2 = (const float*)(const __attribute__((address_space(1))) float*)kp[14];
  q.rwkv_w0 = (const float*)(const __attribute__((address_space(1))) float*)kp[15];
  q.rwkv_a_lora1 = (const float*)(const __attribute__((address_space(1))) float*)kp[16];
  q.rwkv_a_lora2 = (const float*)(const __attribute__((address_space(1))) float*)kp[17];
  q.rwkv_a0 = (const float*)(const __attribute__((address_space(1))) float*)kp[18];
  q.rwkv_k_k = (const float*)(const __attribute__((address_space(1))) float*)kp[19];
  q.rwkv_k_a = (const float*)(const __attribute__((address_space(1))) float*)kp[20];
  q.rwkv_r_k = (const float*)(const __attribute__((address_space(1))) float*)kp[21];
  q.rwkv_ln_gain = (const float*)(const __attribute__((address_space(1))) float*)kp[22];
  q.rwkv_ln_bias = (const float*)(const __attribute__((address_space(1))) float*)kp[23];
  q.rwkv_w_out = (const float*)(const __attribute__((address_space(1))) float*)kp[24];
  q.mla_w_in = (const float*)(const __attribute__((address_space(1))) float*)kp[25];
  q.mla_q_norm = (const float*)(const __attribute__((address_space(1))) float*)kp[26];
  q.mla_kv_norm = (const float*)(const __attribute__((address_space(1))) float*)kp[27];
  q.mla_w_uq = (const float*)(const __attribute__((address_space(1))) float*)kp[28];
  q.mla_w_ukv = (const float*)(const __attribute__((address_space(1))) float*)kp[29];
  q.mla_qk_gain_q = (const float*)(const __attribute__((address_space(1))) float*)kp[30];
  q.mla_qk_gain_k = (const float*)(const __attribute__((address_space(1))) float*)kp[31];
  q.mla_w_out = (const float*)(const __attribute__((address_space(1))) float*)kp[32];
  q.out = (float*)(__attribute__((address_space(1))) float*)kp[33];
  q.ws = (char*)(__attribute__((address_space(1))) char*)kp[34];
  return q;
}

#define XB_TMO      128
#define XB_XCNT(j)  (256  + 64 * (j))
#define XB_XSUB(j)  (1280 + 64 * (j))
#define XB_XGEN(j)  (2304 + 64 * (j))
#define XB_TOP      3328
#define XB_TOPGEN   3392
#define XCD_BAR_WORDS 3456
#define XB_SPIN_CAP (1u << 18)
#define LAS __attribute__((address_space(3)))
DI unsigned xb_ld(unsigned* p)              { return __hip_atomic_load(p, __ATOMIC_RELAXED, __HIP_MEMORY_SCOPE_AGENT); }
DI unsigned xb_add(unsigned* p, unsigned v) { return __hip_atomic_fetch_add(p, v, __ATOMIC_RELAXED, __HIP_MEMORY_SCOPE_AGENT); }
DI unsigned xb_xcc_id() { return (unsigned)__builtin_amdgcn_s_getreg((3 << 11) | 20) & 0xFu; }
#define XB_SPIN(cond, bar) do { unsigned _sp = 0; while (cond) { __builtin_amdgcn_s_sleep(1); \
    if ((++_sp & 255u) == 0u) { if (xb_ld(&(bar)[XB_TMO])) break; if (_sp > XB_SPIN_CAP) { atomicAdd(&(bar)[XB_TMO], 1u); break; } } } } while (0)
struct XcdBarrier { unsigned* bar; unsigned x; volatile LAS unsigned* st; };
DI XcdBarrier xcd_barrier_post(unsigned* bar, volatile LAS unsigned* st) {
  XcdBarrier b; b.bar = bar; b.x = xb_xcc_id(); b.st = st;
  if (threadIdx.x == 0) (void)xb_add(&bar[XB_XCNT(b.x)], 1u);
  return b;
}
DI void xcd_barrier_complete(unsigned* bar, unsigned x, unsigned& nloc, unsigned& nx) {
  const unsigned G = gridDim.x * gridDim.y * gridDim.z;
  unsigned sum, cnt, mine, sp = 0u;
  for (;;) {
    sum = 0u; cnt = 0u; mine = 0u;
#pragma unroll
    for (unsigned j = 0; j < 16; ++j) { const unsigned c = xb_ld(&bar[XB_XCNT(j)]); sum += c; cnt += (c > 0u) ? 1u : 0u; mine = (j == x) ? c : mine; }
    if (sum == G) break;
    __builtin_amdgcn_s_sleep(1);
    if ((++sp & 255u) == 0u) { if (xb_ld(&bar[XB_TMO])) break; if (sp > XB_SPIN_CAP) { atomicAdd(&bar[XB_TMO], 1u); break; } }
  }
  nloc = mine > 0u ? mine : 1u; nx = cnt > 0u ? cnt : 1u;
}
DI void xcd_barrier(const XcdBarrier& b) {
  asm volatile("s_waitcnt vmcnt(0)" ::: "memory");
  __syncthreads();
  if (threadIdx.x == 0) {
    unsigned* bar = b.bar;
    __builtin_amdgcn_s_waitcnt(0);
    unsigned nloc = b.st[0], nx = b.st[1];
    if (nloc == 0u) { xcd_barrier_complete(bar, b.x, nloc, nx); b.st[0] = nloc; b.st[1] = nx; }
    const unsigned old = xb_add(&bar[XB_XSUB(b.x)], 1u);
    const unsigned gen = old / nloc;
    if (old + 1u == (gen + 1u) * nloc) {
      __builtin_amdgcn_fence(__ATOMIC_RELEASE, "agent");
      asm volatile("s_waitcnt vmcnt(0)" ::: "memory");
      const unsigned og = xb_add(&bar[XB_TOP], 1u);
      const unsigned tg = og / nx;
      if (og + 1u == (tg + 1u) * nx) xb_add(&bar[XB_TOPGEN], 1u);
      else XB_SPIN(xb_ld(&bar[XB_TOPGEN]) == tg, bar);
      __builtin_amdgcn_fence(__ATOMIC_ACQUIRE, "agent");
      xb_add(&bar[XB_XGEN(b.x)], 1u);
      asm volatile("s_waitcnt vmcnt(0)" ::: "memory");
    } else {
      XB_SPIN(xb_ld(&bar[XB_XGEN(b.x)]) == gen, bar);
      __builtin_amdgcn_fence(__ATOMIC_ACQUIRE, "agent");
      asm volatile("s_waitcnt vmcnt(0)" ::: "memory");
    }
  }
  __syncthreads();
}

#ifndef ONLY_PH
#define ONLY_PH -1
#endif
#ifndef SKIP_PH
#define SKIP_PH -2
#endif
#ifndef SKIP_PH2
#define SKIP_PH2 -2
#endif
#ifndef PROBE
#define PROBE 0
#endif
#define PH(n) ((ONLY_PH < 0 || ONLY_PH == (n)) && SKIP_PH != (n) && SKIP_PH2 != (n))
__global__ void __launch_bounds__(NTHREADS, LB2) mega(Params p) {
  __shared__ __attribute__((aligned(16))) char smem[SMEM_BYTES];
  cg::grid_group grid = cg::this_grid();
  __shared__ uint4 xb_words;
  if (threadIdx.x == 0) xb_words = make_uint4(0u, 0u, 0u, 0u);
  __syncthreads();
  const XcdBarrier xb = xcd_barrier_post((unsigned*)(p.ws + OFF_BAR), (volatile LAS unsigned*)&xb_words);
  if (PH(0)) { const Params q = ldp(); const u16* W = (const u16*)(q.ws + OFF_W); (void)W; phase_prologue(q, smem); }
  if (p.out == nullptr) grid.sync();
  xcd_barrier(xb);
  if (PH(1)) { const Params q = ldp(); const u16* W = (const u16*)(q.ws + OFF_W); (void)W; phase_norm(q, 0, MALL); }
  xcd_barrier(xb);
  if (PROBE & 32) { const Params q = ldp(); phase_sgu_g1_dry(q, MALL, smem); xcd_barrier(xb); }
  if (PH(2)) { const Params q = ldp(); const u16* W = (const u16*)(q.ws + OFF_W); (void)W; phase_sgu_g1(q, 0, MALL, smem); }
  xcd_barrier(xb);
  if (PH(3)) { const Params q = ldp(); const u16* W = (const u16*)(q.ws + OFF_W); (void)W; phase_sgu_mix(q, 0, MALL, smem); }
  xcd_barrier(xb);
  if (PH(4)) { const Params q = ldp(); const u16* W = (const u16*)(q.ws + OFF_W); (void)W; phase_outproj(q, 0, (const u16*)(q.ws + OFF_GUZ), 2048, W + W_SGUOUT, MALL, smem); }
  xcd_barrier(xb);
  if (PH(5)) { const Params q = ldp(); const u16* W = (const u16*)(q.ws + OFF_W); (void)W; phase_norm(q, 1, MALL); }
  xcd_barrier(xb);
  if (PROBE & 4) { const Params q = ldp(); phase_rwkv_g(q, smem); xcd_barrier(xb); }
  if (PH(6)) { const Params q = ldp(); const u16* W = (const u16*)(q.ws + OFF_W); (void)W; phase_rwkv_g(q, smem); }
  xcd_barrier(xb);
  if (PROBE & 2) { const Params q = ldp(); phase_scan_seq(q, smem); xcd_barrier(xb); }
  if (PH(7)) { const Params q = ldp(); phase_scan_seq(q, smem); }
  xcd_barrier(xb);
  if (PH(10)) { const Params q = ldp(); const u16* W = (const u16*)(q.ws + OFF_W); (void)W; phase_rwkv_ln(q); }
  xcd_barrier(xb);
  if (PH(11)) { const Params q = ldp(); const u16* W = (const u16*)(q.ws + OFF_W); (void)W; phase_outproj(q, 1, (const u16*)(q.ws + OFF_Z), 1024, W + W_ROUT, MALL, smem); }
  xcd_barrier(xb);
  if (PH(12)) { const Params q = ldp(); const u16* W = (const u16*)(q.ws + OFF_W); (void)W; phase_norm(q, 2, MALL); }
  xcd_barrier(xb);
  if (PH(13)) { const Params q = ldp(); const u16* W = (const u16*)(q.ws + OFF_W); (void)W; phase_mla_in(q, smem); }
  xcd_barrier(xb);
#pragma unroll 1
  for (int g = 0; g < 4; ++g) {
    if (PROBE & 8) { const Params q = ldp(); phase_mla_up(q, g, smem); xcd_barrier(xb); }
    if (PH(14)) { const Params q = ldp(); const u16* W = (const u16*)(q.ws + OFF_W); (void)W; phase_mla_up(q, g, smem); }
    xcd_barrier(xb);
    if (PROBE & 1) { const Params q = ldp(); phase_attn(q, g, smem, true); xcd_barrier(xb); }
    if (PH(15)) { const Params q = ldp(); const u16* W = (const u16*)(q.ws + OFF_W); (void)W; phase_attn(q, g, smem); }
    xcd_barrier(xb);
  }
  if (PH(22)) { const Params q = ldp(); const u16* W = (const u16*)(q.ws + OFF_W); (void)W; phase_outproj(q, 2, (const u16*)(q.ws + OFF_SZ), 2048, W + W_MOUT, T, smem); }
  xcd_barrier(xb);
  if (PH(23)) { const Params q = ldp(); const u16* W = (const u16*)(q.ws + OFF_W); (void)W; phase_norm(q, 3, T); }
  xcd_barrier(xb);
  if (PH(24)) { const Params q = ldp(); const u16* W = (const u16*)(q.ws + OFF_W); (void)W; phase_sgu_g1(q, 3, T, smem); }
  xcd_barrier(xb);
  if (PH(25)) { const Params q = ldp(); const u16* W = (const u16*)(q.ws + OFF_W); (void)W; phase_sgu_mix(q, 3, T, smem); }
  xcd_barrier(xb);
  if (PH(26)) { const Params q = ldp(); const u16* W = (const u16*)(q.ws + OFF_W); (void)W; phase_outproj(q, 3, (const u16*)(q.ws + OFF_GUZ), 2048, W + W_SGUOUT + 1024ull * 2048, T, smem); }
}

extern "C" void kernel_launch(void* const* d_in, const int* in_sizes, int n_in, void* d_out, int out_size, void* d_ws, size_t ws_size, hipStream_t stream) {
  static int grid_blocks = 0;
  if (!grid_blocks) {
    int dev = 0, cus = 0, per_cu = 0;
    hipGetDevice(&dev);
    hipDeviceGetAttribute(&cus, hipDeviceAttributeMultiprocessorCount, dev);
    hipOccupancyMaxActiveBlocksPerMultiprocessor(&per_cu, mega, NTHREADS, 0);
    if (per_cu > 2) per_cu = 2;
    if (per_cu < 1) per_cu = 1;
    grid_blocks = cus * per_cu;
  }
  Params p{};
  const float** f = (const float**)&p;
  for (int i = 0; i < 33; ++i) f[i] = (const float*)d_in[i];
  p.out = (float*)d_out;
  p.ws = (char*)d_ws;
  hipMemsetAsync((char*)d_ws + OFF_BAR, 0, XCD_BAR_WORDS * 4, stream);
  void* args[] = {&p};
  hipError_t e = hipLaunchCooperativeKernel((void*)mega, dim3(grid_blocks), dim3(NTHREADS), args, 0, stream);
  if (e != hipSuccess) fprintf(stderr, "cooperative launch failed: %s (grid %d)\n", hipGetErrorString(e), grid_blocks);
}
```

```cpp
#include <hip/hip_runtime.h>
#include <hip/hip_cooperative_groups.h>
#include <cstdio>
#include <cstdint>
namespace cg = cooperative_groups;

#define DI __device__ __forceinline__
typedef unsigned short u16;
typedef short bf16x8 __attribute__((ext_vector_type(8)));
typedef float f32x16 __attribute__((ext_vector_type(16)));
typedef float f32x4 __attribute__((ext_vector_type(4)));
typedef float f32x2 __attribute__((ext_vector_type(2)));
typedef unsigned u32x4 __attribute__((ext_vector_type(4)));
typedef unsigned u32x2 __attribute__((ext_vector_type(2)));
typedef _Float16 h16;
typedef _Float16 h16x8 __attribute__((ext_vector_type(8)));
typedef _Float16 h16x4 __attribute__((ext_vector_type(4)));

constexpr int D = 1024, NB = 8, SEQ = 8192, CTXL = 256;
constexpr int T = NB * SEQ;
constexpr int TC = NB * CTXL;
constexpr int MALL = T + TC;
constexpr int SMEM_BYTES = 73728;
constexpr int NTHREADS = 256;
#ifndef LB2
#define LB2 2
#endif

constexpr size_t MB = 1ull << 20;
constexpr size_t OFF_W = 0;
constexpr size_t W_SGUIN = 0;
constexpr size_t W_SGUOUT = W_SGUIN + 2ull * 6144 * 1024;
constexpr size_t W_RIN = W_SGUOUT + 2ull * 1024 * 2048;
constexpr size_t W_L1W = W_RIN + 4ull * 1024 * 1024;
constexpr size_t W_L1A = W_L1W + 128ull * 1024;
constexpr size_t W_ROUT = W_L1A + 128ull * 1024;
constexpr size_t W_MIN = W_ROUT + 1024ull * 1024;
constexpr size_t W_UQ = W_MIN + 3200ull * 1024;
constexpr size_t W_UKV = W_UQ + 3072ull * 768;
constexpr size_t W_MOUT = W_UKV + 4096ull * 256;
constexpr size_t W_L2W = W_MOUT + 1024ull * 2048;
constexpr size_t W_L2A = W_L2W + 2ull * 1024 * 64;
constexpr size_t W_END = W_L2A + 2ull * 1024 * 64;
static_assert(W_END * 2 <= 64 * MB, "weights region");
constexpr size_t OFF_MOD = 64 * MB;
constexpr size_t OFF_CS = OFF_MOD + 512 * 1024;
constexpr size_t OFF_MU16 = OFF_CS + 32 * 1024;
constexpr size_t OFF_BAR = OFF_CS + 48 * 1024;
constexpr size_t OFF_SSQA = OFF_CS + 64 * 1024;
constexpr size_t OFF_SSQB = OFF_SSQA + 512 * 1024;
constexpr size_t OFF_SSQR = OFF_SSQB + 512 * 1024;
constexpr size_t OFF_CTX = 66 * MB;
constexpr size_t OFF_BIG = 76 * MB;
constexpr size_t SZ_ACT = (size_t)MALL * 1024 * 2;
constexpr size_t OFF_H = OFF_BIG;
constexpr size_t OFF_GUZ = OFF_H + SZ_ACT;
constexpr size_t OFF_GVT = OFF_GUZ + 2 * SZ_ACT;
constexpr size_t OFF_R = OFF_H + SZ_ACT;
constexpr size_t OFF_K = OFF_R + SZ_ACT;
constexpr size_t OFF_V = OFF_K + SZ_ACT;
constexpr size_t OFF_Z = OFF_V + SZ_ACT;
constexpr size_t OFF_TW = OFF_Z + SZ_ACT;
constexpr size_t OFF_TA = OFF_TW + (size_t)MALL * 128 * 2;
constexpr size_t OFF_BS = OFF_TA + (size_t)MALL * 128 * 2;
constexpr size_t OFF_SUMM = OFF_BS + (size_t)MALL * 32 * 4;
constexpr size_t OFF_Y1 = OFF_SUMM;
constexpr int NUNIT = NB * 16 * 33;
constexpr size_t RWKV_END = OFF_SUMM + (size_t)NUNIT * 4 * 4096 * 2;
constexpr size_t OFF_CQ = OFF_H + SZ_ACT;
constexpr size_t OFF_CKV = OFF_CQ + (size_t)T * 768 * 2;
constexpr size_t OFF_KR = OFF_CKV + (size_t)MALL * 256 * 2;
constexpr size_t OFF_SZ = OFF_KR + (size_t)MALL * 64 * 4;
constexpr size_t OFF_QX = OFF_SZ + (size_t)T * 2048 * 2;
constexpr size_t OFF_KX = OFF_QX + 16384ull * 16 * 256 * 2;
constexpr size_t OFF_VT = OFF_KX + 2ull * 8448 * 16 * 192 * 2;
constexpr size_t MLA_END = OFF_VT + 2ull * 16 * 128 * 8448 * 2;
constexpr size_t WS_NEED = (RWKV_END > MLA_END ? RWKV_END : MLA_END);
static_assert(WS_NEED <= 1024 * MB, "workspace");
static_assert(OFF_GVT + 2 * SZ_ACT <= 1024 * MB, "workspace sgu");

struct Params {
  const float *x, *c, *ctx, *c_ctx, *ada_w, *ada_b;
  const float *sgu_w_in, *sgu_gain, *sgu_w_s, *sgu_b_s, *sgu_w_out;
  const float *rwkv_mu, *rwkv_w_in, *rwkv_w_lora1, *rwkv_w_lora2, *rwkv_w0, *rwkv_a_lora1, *rwkv_a_lora2, *rwkv_a0;
  const float *rwkv_k_k, *rwkv_k_a, *rwkv_r_k, *rwkv_ln_gain, *rwkv_ln_bias, *rwkv_w_out;
  const float *mla_w_in, *mla_q_norm, *mla_kv_norm, *mla_w_uq, *mla_w_ukv, *mla_qk_gain_q, *mla_qk_gain_k, *mla_w_out;
  float* out;
  char* ws;
};

DI u16 f2bf(float x) { unsigned u = __float_as_uint(x); u += 0x7fffu + ((u >> 16) & 1u); return (u16)(u >> 16); }
typedef __bf16 bf16x2_t __attribute__((ext_vector_type(2)));
DI unsigned pack2bf(float a, float b) { const f32x2 v = (f32x2){a, b}; return __builtin_bit_cast(unsigned, __builtin_convertvector(v, bf16x2_t)); }
DI float bflo(unsigned v) { return __uint_as_float(v << 16); }
DI float bfhi(unsigned v) { return __uint_as_float(v & 0xffff0000u); }
DI float sigmoidf_(float x) { return __builtin_amdgcn_rcpf(1.0f + __builtin_amdgcn_exp2f(-1.4426950408889634f * x)); }
DI float siluf_(float x) { return x * sigmoidf_(x); }
DI float geluf_(float x) { const float u = 0.7978845608028654f * (x + 0.044715f * x * x * x); return x * sigmoidf_(2.0f * u); }
DI int crow(int i, int h) { return (i & 3) + 8 * (i >> 2) + 4 * h; }
DI float wave_sum(float v) {
#pragma unroll
  for (int o = 32; o >= 1; o >>= 1) v += __shfl_xor(v, o);
  return v;
}
#define MFMA(a, b, c) __builtin_amdgcn_mfma_f32_32x32x16_bf16((a), (b), (c), 0, 0, 0)

DI int mod_row(int row) { return row < T ? (row >> 13) : 8; }

constexpr int LROW = 144;
template <int MI, int NI, bool F16 = false, class XL, class EPI>
DI void gemm_tile(const XL& xl, const u16* __restrict__ Wt, int ldw, int K, const EPI& epi, char* smem) {
  constexpr int BN = NI * 32, BM = MI * 128;
  constexpr int WCH = BN * 8 / NTHREADS, XCH = BM * 8 / NTHREADS;
  int tid_ = threadIdx.x; asm volatile("" : "+v"(tid_));
  const int tid = tid_, lane = tid & 63, w = tid >> 6, r = lane & 31, h = lane >> 5;
  char* Xs = smem;
  char* Ws = smem + BM * LROW;
  u32x4 xr[XCH], wr[WCH];
  f32x16 acc[MI][NI];
#pragma unroll
  for (int mi = 0; mi < MI; ++mi)
#pragma unroll
    for (int ni = 0; ni < NI; ++ni)
#pragma unroll
      for (int i = 0; i < 16; ++i) acc[mi][ni][i] = 0.f;
#pragma unroll
  for (int j = 0; j < XCH; ++j) { const int c = tid + NTHREADS * j; xr[j] = xl(c >> 3, (c & 7) * 8); }
#pragma unroll
  for (int j = 0; j < WCH; ++j) { const int c = tid + NTHREADS * j; wr[j] = *(const u32x4*)(Wt + (unsigned)((c >> 3) * ldw + (c & 7) * 8)); }
  for (int k0 = 0; k0 < K; k0 += 64) {
    __syncthreads();
#pragma unroll
    for (int j = 0; j < XCH; ++j) { const int c = tid + NTHREADS * j; *(u32x4*)(Xs + (c >> 3) * LROW + (c & 7) * 16) = xr[j]; }
#pragma unroll
    for (int j = 0; j < WCH; ++j) { const int c = tid + NTHREADS * j; *(u32x4*)(Ws + (c >> 3) * LROW + (c & 7) * 16) = wr[j]; }
    if (k0 + 64 < K) {
#pragma unroll
      for (int j = 0; j < XCH; ++j) { const int c = tid + NTHREADS * j; xr[j] = xl(c >> 3, k0 + 64 + (c & 7) * 8); }
#pragma unroll
      for (int j = 0; j < WCH; ++j) { const int c = tid + NTHREADS * j; wr[j] = *(const u32x4*)(Wt + (unsigned)((c >> 3) * ldw + k0 + 64 + (c & 7) * 8)); }
    }
    __syncthreads();
#pragma unroll
    for (int s = 0; s < 4; ++s) {
      bf16x8 xf[MI];
#pragma unroll
      for (int mi = 0; mi < MI; ++mi) xf[mi] = *(const bf16x8*)(Xs + (32 * (MI * w + mi) + r) * LROW + (16 * s + 8 * h) * 2);
#pragma unroll
      for (int ni = 0; ni < NI; ++ni) {
        const bf16x8 wf = *(const bf16x8*)(Ws + (32 * ni + r) * LROW + (16 * s + 8 * h) * 2);
#pragma unroll
        for (int mi = 0; mi < MI; ++mi) {
          if (F16) acc[mi][ni] = __builtin_amdgcn_mfma_f32_32x32x16_f16(__builtin_bit_cast(h16x8, wf), __builtin_bit_cast(h16x8, xf[mi]), acc[mi][ni], 0, 0, 0);
          else acc[mi][ni] = MFMA(wf, xf[mi], acc[mi][ni]);
        }
        if (NI == 8 && (ni & 3) == 3) __builtin_amdgcn_sched_barrier(0);
      }
    }
  }
#pragma unroll
  for (int mi = 0; mi < MI; ++mi) epi(acc[mi], MI * w + mi, r, h);
}


typedef __attribute__((address_space(3))) void* lds_ptr_t;
typedef const __attribute__((address_space(1))) void* glb_ptr_t;
constexpr int GL_STAGE = 24576;
template <class EPI>
DI void gemm_tile_glds(const u16* __restrict__ X, int ldx, const u16* __restrict__ Wt, int ldw, int K, const EPI& epi, char* smem) {
  int tid_ = threadIdx.x; asm volatile("" : "+v"(tid_));
  const int tid = tid_, lane = tid & 63, w = tid >> 6, r = lane & 31, h = lane >> 5;
  const int cs = (tid & 3) ^ ((tid >> 4) & 3);
  const u16* gx = X + (unsigned)((tid >> 2) * ldx + cs * 8);
  const u16* gw = Wt + (unsigned)((tid >> 2) * ldw + cs * 8);
  char* ldst = smem + tid * 16;
  f32x16 acc[2][4];
#pragma unroll
  for (int mi = 0; mi < 2; ++mi)
#pragma unroll
    for (int ni = 0; ni < 4; ++ni)
#pragma unroll
      for (int i = 0; i < 16; ++i) acc[mi][ni][i] = 0.f;
  const int NK = K >> 5;
  auto issue = [&](int kt) {
    char* d = ldst + (kt % 3) * GL_STAGE;
    const u16* sx = gx + kt * 32; const u16* sw = gw + kt * 32;
#pragma unroll
    for (int i = 0; i < 4; ++i) __builtin_amdgcn_global_load_lds((glb_ptr_t)(sx + (unsigned)(i * 64 * ldx)), (lds_ptr_t)(d + i * 4096), 16, 0, 0);
#pragma unroll
    for (int i = 0; i < 2; ++i) __builtin_amdgcn_global_load_lds((glb_ptr_t)(sw + (unsigned)(i * 64 * ldw)), (lds_ptr_t)(d + 16384 + i * 4096), 16, 0, 0);
  };
  asm volatile("s_waitcnt vmcnt(0)" ::: "memory");
  __builtin_amdgcn_s_barrier();
  asm volatile("" ::: "memory");
  issue(0); issue(1);
  const int swz = (r >> 2) & 3;
  int xo2[2], wo2[2];
#pragma unroll
  for (int s2 = 0; s2 < 2; ++s2) { const int cofs = ((2 * s2 + h) ^ swz) << 4; xo2[s2] = (64 * w + r) * 64 + cofs; wo2[s2] = 16384 + r * 64 + cofs; }
#pragma unroll 1
  for (int kt = 0; kt < NK; ++kt) {
    if (kt + 1 < NK) asm volatile("s_waitcnt vmcnt(6)" ::: "memory"); else asm volatile("s_waitcnt vmcnt(0)" ::: "memory");
    __builtin_amdgcn_s_barrier();
    asm volatile("" ::: "memory");
    if (kt + 2 < NK) issue(kt + 2);
    const char* sb = smem + (kt % 3) * GL_STAGE;
#pragma unroll
    for (int s2 = 0; s2 < 2; ++s2) {
      bf16x8 xf[2];
#pragma unroll
      for (int mi = 0; mi < 2; ++mi) xf[mi] = *(const bf16x8*)(sb + xo2[s2] + mi * 2048);
#pragma unroll
      for (int ni = 0; ni < 4; ++ni) {
        const bf16x8 wf = *(const bf16x8*)(sb + wo2[s2] + ni * 2048);
#pragma unroll
        for (int mi = 0; mi < 2; ++mi) acc[mi][ni] = MFMA(wf, xf[mi], acc[mi][ni]);
      }
    }
    asm volatile("" ::: "memory");
  }
#pragma unroll
  for (int mi = 0; mi < 2; ++mi) epi(acc[mi], 2 * w + mi, r, h);
}

struct XPlain {
  const u16* base; int ld;
  DI u32x4 operator()(int row, int k) const { return *(const u32x4*)(base + (unsigned)(row * ld + k)); }
};

struct Job { const float* src; u16* dst; int K, Nsrc, Ndst, map; const float* scale; int f16; };
constexpr int NJOBS = 21;
DI Job get_job(const Params& p, int j) {
  u16* W = (u16*)(p.ws + OFF_W);
  Job jb; jb.scale = nullptr; jb.map = 0; jb.f16 = 0;
  if (j < 2) { jb.src = p.sgu_w_in + (size_t)j * 1024 * 6144; jb.dst = W + W_SGUIN + (size_t)j * 6144 * 1024; jb.K = 1024; jb.Nsrc = 6144; jb.Ndst = 6144; jb.map = 1; }
  else if (j < 4) { jb.src = p.sgu_w_out + (size_t)(j - 2) * 2048 * 1024; jb.dst = W + W_SGUOUT + (size_t)(j - 2) * 1024 * 2048; jb.K = 2048; jb.Nsrc = 1024; jb.Ndst = 1024; }
  else if (j < 8) { jb.src = p.rwkv_w_in + (size_t)(j - 4) * 1024 * 1024; jb.dst = W + W_RIN + (size_t)(j - 4) * 1024 * 1024; jb.K = 1024; jb.Nsrc = 1024; jb.Ndst = 1024; }
  else if (j < 10) { jb.src = p.rwkv_w_lora1 + (size_t)(j - 8) * 1024 * 64; jb.dst = W + W_L1W + (size_t)(j - 8) * 64 * 1024; jb.K = 1024; jb.Nsrc = 64; jb.Ndst = 64; }
  else if (j < 12) { jb.src = p.rwkv_a_lora1 + (size_t)(j - 10) * 1024 * 64; jb.dst = W + W_L1A + (size_t)(j - 10) * 64 * 1024; jb.K = 1024; jb.Nsrc = 64; jb.Ndst = 64; }
  else if (j == 12) { jb.src = p.rwkv_w_out; jb.dst = W + W_ROUT; jb.K = 1024; jb.Nsrc = 1024; jb.Ndst = 1024; }
  else if (j == 13) { jb.src = p.mla_w_in; jb.dst = W + W_MIN; jb.K = 1024; jb.Nsrc = 3136; jb.Ndst = 3200; jb.map = 2; }
  else if (j == 14) { jb.src = p.mla_w_uq; jb.dst = W + W_UQ; jb.K = 768; jb.Nsrc = 3072; jb.Ndst = 3072; jb.scale = p.mla_q_norm; }
  else if (j == 15) { jb.src = p.mla_w_ukv; jb.dst = W + W_UKV; jb.K = 256; jb.Nsrc = 4096; jb.Ndst = 4096; jb.scale = p.mla_kv_norm; }
  else if (j == 16) { jb.src = p.mla_w_out; jb.dst = W + W_MOUT; jb.K = 2048; jb.Nsrc = 1024; jb.Ndst = 1024; }
  else if (j < 19) { jb.src = p.rwkv_w_lora2 + (size_t)(j - 17) * 64 * 1024; jb.dst = W + W_L2W + (size_t)(j - 17) * 1024 * 64; jb.K = 64; jb.Nsrc = 1024; jb.Ndst = 1024; jb.f16 = 1; }
  else { jb.src = p.rwkv_a_lora2 + (size_t)(j - 19) * 64 * 1024; jb.dst = W + W_L2A + (size_t)(j - 19) * 1024 * 64; jb.K = 64; jb.Nsrc = 1024; jb.Ndst = 1024; jb.f16 = 1; }
  return jb;
}
DI int map_col(int map, int n) {
  if (map == 0) return n;
  if (map == 1) {
    if (n >= 4096) return 2048 + (n - 4096);
    const int nt = n >> 7, j = n & 127, pp = j >> 6, ns = (j >> 5) & 1, cc = j & 31;
    const int ch = nt * 64 + pp * 32 + cc;
    return ns ? 4096 + ch : ch;
  }
  if (n < 1024) return n;
  if (n < 3072) return n + 64;
  if (n < 3136) return n - 2048;
  return -1;
}

DI void phase_prologue(const Params& p, char* smem) {
  const int tid = threadIdx.x;
  for (int item = blockIdx.x; ; item += gridDim.x) {
    if (item < 48) {
      float* cs = (float*)smem;
      for (int i = tid; i < 9 * 1024; i += NTHREADS) { const float v = i < 8192 ? p.c[i] : p.c_ctx[i - 8192]; cs[i] = siluf_(v); }
      __syncthreads();
      const int gi = item * 256 + tid; const int l = gi / 3072, n = gi % 3072;
      const float* wp = p.ada_w + (size_t)l * 1024 * 3072 + n;
      float a[9];
#pragma unroll
      for (int m = 0; m < 9; ++m) a[m] = p.ada_b[l * 3072 + n];
#pragma unroll 32
      for (int k = 0; k < 1024; ++k) { const float wv = wp[(size_t)k * 3072];
#pragma unroll
        for (int m = 0; m < 9; ++m) a[m] += cs[m * 1024 + k] * wv; }
      float* mo = (float*)(p.ws + OFF_MOD);
#pragma unroll
      for (int m = 0; m < 9; ++m) mo[((size_t)l * 9 + m) * 3072 + n] = a[m];
      __syncthreads();
      continue;
    }
    if (item == 48) {
      f32x2* cs = (f32x2*)(p.ws + OFF_CS);
      for (int i = tid; i < 3072; i += NTHREADS) {
        const int pos = i < 2048 ? (i >> 4) : ((i - 2048) >> 4); const int f = i & 15;
        const float invf = exp2f(-(float)f * (13.287712379549449f / 16.0f));
        const float ang = (float)pos * invf; float s, c; sincosf(ang, &s, &c);
        cs[i] = (f32x2){c, s};
      }
      h16* mu16 = (h16*)(p.ws + OFF_MU16);
      for (int i = tid; i < 6 * 1024; i += NTHREADS) mu16[i] = (h16)p.rwkv_mu[i];
      continue;
    }
    int ti = item - 49; int j = 0; Job jb;
    for (; j < NJOBS; ++j) { jb = get_job(p, j); const int nt = (jb.Ndst / 64) * (jb.K / 64); if (ti < nt) break; ti -= nt; }
    if (j >= NJOBS) break;
    const int nkt = jb.K / 64; const int nt = ti / nkt, kt = ti % nkt;
    float* tile = (float*)smem;
#pragma unroll 4
    for (int q = 0; q < 16; ++q) {
      const int kk = (tid >> 6) + 4 * q, nn = tid & 63; const int sc = map_col(jb.map, nt * 64 + nn); const int k = kt * 64 + kk;
      float v = 0.f; if (sc >= 0) { v = jb.src[(size_t)k * jb.Nsrc + sc]; if (jb.scale) v *= jb.scale[k]; }
      tile[nn * 65 + kk] = v;
    }
    __syncthreads();
    { const int nn = tid >> 2, kq = tid & 3; unsigned o[8];
#pragma unroll
      for (int q = 0; q < 8; ++q) { const float a = tile[nn * 65 + kq * 16 + 2 * q], b = tile[nn * 65 + kq * 16 + 2 * q + 1];
        if (jb.f16) { const h16 ha = (h16)a, hb = (h16)b; o[q] = (unsigned)__builtin_bit_cast(u16, ha) | ((unsigned)__builtin_bit_cast(u16, hb) << 16); } else o[q] = pack2bf(a, b); }
      u32x4* dp = (u32x4*)(jb.dst + (size_t)(nt * 64 + nn) * jb.K + kt * 64 + kq * 16);
      dp[0] = (u32x4){o[0], o[1], o[2], o[3]}; dp[1] = (u32x4){o[4], o[5], o[6], o[7]}; }
    __syncthreads();
  }
}

DI void phase_norm(const Params& p, int l, int nrows) {
  const int lane = threadIdx.x & 63, w = threadIdx.x >> 6;
  const float* mo = (const float*)(p.ws + OFF_MOD) + (size_t)l * 9 * 3072;
  u16* H = (u16*)(p.ws + OFF_H);
  float* sa = (float*)(p.ws + OFF_SSQA); float* sb = (float*)(p.ws + OFF_SSQB);
  for (int row = blockIdx.x * 4 + w; row < nrows; row += gridDim.x * 4) {
    const float* xs = row < T ? ((l == 0 ? p.x : p.out) + (size_t)row * D) : ((l == 0 ? p.ctx : (const float*)(p.ws + OFF_CTX)) + (size_t)(row - T) * D);
    f32x4 v[4]; float ss = 0.f;
#pragma unroll
    for (int j = 0; j < 4; ++j) { v[j] = *(const f32x4*)(xs + lane * 4 + 256 * j); ss += v[j][0] * v[j][0] + v[j][1] * v[j][1] + v[j][2] * v[j][2] + v[j][3] * v[j][3]; }
    ss = wave_sum(ss);
    const float rinv = rsqrtf(ss * (1.0f / 1024.0f) + 1e-6f);
    const float* m = mo + (size_t)mod_row(row) * 3072;
#pragma unroll
    for (int j = 0; j < 4; ++j) {
      const int cidx = lane * 4 + 256 * j;
      const f32x4 sh = *(const f32x4*)(m + cidx), sc = *(const f32x4*)(m + 1024 + cidx);
      float o[4];
#pragma unroll
      for (int e = 0; e < 4; ++e) o[e] = v[j][e] * rinv * (1.0f + sc[e]) + sh[e];
      *(u32x2*)(H + (size_t)row * D + cidx) = (u32x2){pack2bf(o[0], o[1]), pack2bf(o[2], o[3])};
    }
    if (lane == 0) { sa[row] = 0.f; sb[row] = 0.f; }
  }
}

DI void stagger(int nsleep) { if (blockIdx.x >= 256) for (int i = 0; i < nsleep; ++i) __builtin_amdgcn_s_sleep(127); }
struct EpiResidual {
  const Params* p; int l, m0, n0;
  DI void operator()(const f32x16 (&acc)[4], int w, int r, int h) const {
    const int row = m0 + 32 * w + r;
    const float* xin; float* xo;
    if (row < T) { xin = (l == 0 ? p->x : p->out) + (size_t)row * D; xo = p->out + (size_t)row * D; }
    else { xin = (l == 0 ? p->ctx : (const float*)(p->ws + OFF_CTX)) + (size_t)(row - T) * D; xo = (float*)(p->ws + OFF_CTX) + (size_t)(row - T) * D; }
    const float* g = (const float*)(p->ws + OFF_MOD) + ((size_t)l * 9 + mod_row(row)) * 3072 + 2048;
#pragma unroll
    for (int hf = 0; hf < 2; ++hf) {
      f32x4 xv[8], gv[8];
#pragma unroll
      for (int j = 0; j < 8; ++j) { const int ni = 2 * hf + (j >> 2), q = j & 3; const int n = n0 + 32 * ni + 8 * q + 4 * h; xv[j] = *(const f32x4*)(xin + n); gv[j] = *(const f32x4*)(g + n); }
#pragma unroll
      for (int j = 0; j < 8; ++j) { const int ni = 2 * hf + (j >> 2), q = j & 3; const int n = n0 + 32 * ni + 8 * q + 4 * h;
        f32x4 o;
#pragma unroll
        for (int e = 0; e < 4; ++e) o[e] = xv[j][e] + gv[j][e] * acc[ni][4 * q + e];
        *(f32x4*)(xo + n) = o; }
    }
  }
};
struct EpiResidual8 {
  EpiResidual a, b;
  DI void operator()(const f32x16 (&acc)[8], int w, int r, int h) const {
    a(reinterpret_cast<const f32x16 (&)[4]>(acc[0]), w, r, h);
    __builtin_amdgcn_sched_barrier(0);
    b(reinterpret_cast<const f32x16 (&)[4]>(acc[4]), w, r, h);
  }
};
DI void phase_outproj(const Params& p, int l, const u16* X, int K, const u16* Wt, int nrows, char* smem) {
  const int ntile = (nrows / 128) * 4;
  for (int t = blockIdx.x; t < ntile; t += gridDim.x) {
    const int xcd = t & 7, lg = t >> 3; const int mt = (lg >> 2) * 8 + xcd, n2 = lg & 3;
    XPlain xl{X + (size_t)mt * 128 * K, K};
    EpiResidual8 ep{EpiResidual{&p, l, mt * 128, n2 * 256}, EpiResidual{&p, l, mt * 128, n2 * 256 + 128}};
    gemm_tile<1, 8>(xl, Wt + (size_t)n2 * 256 * K, K, K, ep, smem);
  }
}

struct EpiSguUZ {
  u16* guz; int m0, nt;
  DI void operator()(const f32x16 (&acc)[4], int w, int r, int h) const {
    const int row = m0 + 32 * w + r;
#pragma unroll
    for (int pp = 0; pp < 2; ++pp)
#pragma unroll
      for (int q = 0; q < 4; ++q) {
        float o[4];
#pragma unroll
        for (int e = 0; e < 4; ++e) {
          const float u = acc[2 * pp][4 * q + e], z = acc[2 * pp + 1][4 * q + e];
          const float a2 = 1.5957691216057308f * (u + 0.044715f * u * u * u);
          const float e1 = __builtin_amdgcn_exp2f(-1.4426950408889634f * a2), e2 = __builtin_amdgcn_exp2f(-1.4426950408889634f * z);
          const float den = fminf((1.0f + e1) * (1.0f + e2), 3.0e38f);
          o[e] = u * z * __builtin_amdgcn_rcpf(den);
        }
        *(u32x2*)(guz + (size_t)row * 2048 + nt * 64 + 32 * pp + 8 * q + 4 * h) = (u32x2){pack2bf(o[0], o[1]), pack2bf(o[2], o[3])};
      }
  }
};
struct EpiSguV {
  u16* gvt; float* ssq; int m0, c0;
  DI void operator()(const f32x16 (&acc)[4], int w, int r, int h) const {
    const int qrow = 32 * w + r; const int chunk = (m0 + qrow) >> 7; const int qpos = qrow & 127;
    float ss = 0.f;
#pragma unroll
    for (int ni = 0; ni < 4; ++ni)
#pragma unroll
      for (int i = 0; i < 16; ++i) {
        const float g = geluf_(acc[ni][i]); ss += g * g;
        gvt[((size_t)chunk * 2048 + c0 + 32 * ni + crow(i, h)) * 128 + qpos] = f2bf(g);
      }
    ss += __shfl_xor(ss, 32);
    if (h == 0) atomicAdd(ssq + m0 + qrow, ss);
  }
};
struct EpiSguUZ8 {
  EpiSguUZ a, b;
  DI void operator()(const f32x16 (&acc)[8], int w, int r, int h) const {
    a(reinterpret_cast<const f32x16 (&)[4]>(acc[0]), w, r, h);
    __builtin_amdgcn_sched_barrier(0);
    b(reinterpret_cast<const f32x16 (&)[4]>(acc[4]), w, r, h);
  }
};
struct EpiSguV8 {
  EpiSguV a, b;
  DI void operator()(const f32x16 (&acc)[8], int w, int r, int h) const {
    a(reinterpret_cast<const f32x16 (&)[4]>(acc[0]), w, r, h);
    __builtin_amdgcn_sched_barrier(0);
    b(reinterpret_cast<const f32x16 (&)[4]>(acc[4]), w, r, h);
  }
};
DI void phase_sgu_g1(const Params& p, int l, int nrows, char* smem) {
  const u16* H = (const u16*)(p.ws + OFF_H);
  const u16* Wt = (const u16*)(p.ws + OFF_W) + W_SGUIN + (size_t)(l ? 1 : 0) * 6144 * 1024;
  const int ntile = (nrows / 128) * 24;
  for (int t = blockIdx.x; t < ntile; t += gridDim.x) {
    const int mt = t / 24, n2 = t % 24;
    XPlain xl{H + (size_t)mt * 128 * D, D};
    const u16* wp = Wt + (size_t)n2 * 256 * D;
    if (n2 < 16) {
      EpiSguUZ8 ep{EpiSguUZ{(u16*)(p.ws + OFF_GUZ), mt * 128, 2 * n2}, EpiSguUZ{(u16*)(p.ws + OFF_GUZ), mt * 128, 2 * n2 + 1}};
      gemm_tile<1, 8>(xl, wp, D, D, ep, smem);
    } else {
      const int c0 = (n2 - 16) * 256;
      EpiSguV8 ep{EpiSguV{(u16*)(p.ws + OFF_GVT), (float*)(p.ws + OFF_SSQA), mt * 128, c0}, EpiSguV{(u16*)(p.ws + OFF_GVT), (float*)(p.ws + OFF_SSQA), mt * 128, c0 + 128}};
      gemm_tile<1, 8>(xl, wp, D, D, ep, smem);
    }
  }
}
struct EpiNull {
  float* sink;
  DI void operator()(const f32x16 (&acc)[4], int w, int r, int h) const {
    float t = 0.f;
#pragma unroll
    for (int ni = 0; ni < 4; ++ni)
#pragma unroll
      for (int i = 0; i < 16; ++i) t += acc[ni][i];
    if (t == 1.2345e38f) sink[threadIdx.x] = t;
  }
};
DI void phase_sgu_g1_dry(const Params& p, int nrows, char* smem) {
  const u16* H = (const u16*)(p.ws + OFF_H);
  const u16* Wt = (const u16*)(p.ws + OFF_W) + W_SGUIN;
  const int ntile = (nrows / 256) * 48;
  for (int t = blockIdx.x; t < ntile; t += gridDim.x) {
    const int mt = t / 48, nt = t % 48;
    EpiNull ep{(float*)(p.ws + OFF_SSQR)};
    gemm_tile_glds(H + (size_t)mt * 256 * D, D, Wt + (size_t)nt * 128 * D, D, D, ep, smem);
  }
}
struct XSguMix {
  const float* ws_g; const float* rinv;
  DI u32x4 operator()(int row, int k) const {
    const f32x4 a = *(const f32x4*)(ws_g + row * 128 + k), b = *(const f32x4*)(ws_g + row * 128 + k + 4);
    const f32x4 ra = *(const f32x4*)(rinv + k), rb = *(const f32x4*)(rinv + k + 4);
    return (u32x4){pack2bf(a[0] * ra[0], a[1] * ra[1]), pack2bf(a[2] * ra[2], a[3] * ra[3]), pack2bf(b[0] * rb[0], b[1] * rb[1]), pack2bf(b[2] * rb[2], b[3] * rb[3])};
  }
};
struct EpiSguMix {
  u16* guz; const float* gain; const float* bs_g; int m0, c0;
  DI void operator()(const f32x16 (&acc)[4], int w, int r, int h) const {
    const int pp = 32 * w + r; const float bias = bs_g[pp];
    u16* rowp = guz + (size_t)(m0 + pp) * 2048 + c0;
    u32x2 gz[16];
#pragma unroll
    for (int j = 0; j < 16; ++j) gz[j] = *(const u32x2*)(rowp + 32 * (j >> 2) + 8 * (j & 3) + 4 * h);
#pragma unroll
    for (int j = 0; j < 16; ++j) {
      const int ni = j >> 2, q = j & 3; const int n = 32 * ni + 8 * q + 4 * h;
      const f32x4 gn = *(const f32x4*)(gain + c0 + n);
      const float o0 = (acc[ni][4 * q] * gn[0] + bias) * bflo(gz[j][0]), o1 = (acc[ni][4 * q + 1] * gn[1] + bias) * bfhi(gz[j][0]);
      const float o2 = (acc[ni][4 * q + 2] * gn[2] + bias) * bflo(gz[j][1]), o3 = (acc[ni][4 * q + 3] * gn[3] + bias) * bfhi(gz[j][1]);
      *(u32x2*)(rowp + n) = (u32x2){pack2bf(o0, o1), pack2bf(o2, o3)};
    }
  }
};
struct EpiSguMix8 {
  u16* guz; const float* gain; const float* bs_g; int m0, c0;
  DI void operator()(const f32x16 (&acc)[8], int w, int r, int h) const {
    const int pp = 32 * w + r; const float bias = bs_g[pp];
    u16* rowp = guz + (size_t)(m0 + pp) * 2048 + c0;
#pragma unroll
    for (int hf = 0; hf < 2; ++hf) {
      u32x2 gz[16];
#pragma unroll
      for (int j = 0; j < 16; ++j) gz[j] = *(const u32x2*)(rowp + 128 * hf + 32 * (j >> 2) + 8 * (j & 3) + 4 * h);
#pragma unroll
      for (int j = 0; j < 16; ++j) {
        const int ni = 4 * hf + (j >> 2), q = j & 3; const int n = 32 * ni + 8 * q + 4 * h;
        const f32x4 gn = *(const f32x4*)(gain + c0 + n);
        const float o0 = (acc[ni][4 * q] * gn[0] + bias) * bflo(gz[j][0]), o1 = (acc[ni][4 * q + 1] * gn[1] + bias) * bfhi(gz[j][0]);
        const float o2 = (acc[ni][4 * q + 2] * gn[2] + bias) * bflo(gz[j][1]), o3 = (acc[ni][4 * q + 3] * gn[3] + bias) * bfhi(gz[j][1]);
        *(u32x2*)(rowp + n) = (u32x2){pack2bf(o0, o1), pack2bf(o2, o3)};
      }
    }
  }
};
DI void phase_sgu_mix(const Params& p, int l, int nrows, char* smem) {
  const int lj = l ? 1 : 0;
  const float* ssq = (const float*)(p.ws + OFF_SSQA);
  float* rinv = (float*)(smem + 57344);
  const int ntile = (nrows / 128) * 8;
  for (int t = blockIdx.x; t < ntile; t += gridDim.x) {
    const int chunk = t >> 3, g = t & 7;
    __syncthreads();
    if (threadIdx.x < 128) rinv[threadIdx.x] = rsqrtf(ssq[chunk * 128 + threadIdx.x] * (1.0f / 2048.0f) + 1e-6f);
    __syncthreads();
    XSguMix xl{p.sgu_w_s + ((size_t)lj * 8 + g) * 128 * 128, rinv};
    const int c0 = g * 256;
    EpiSguMix8 ep{(u16*)(p.ws + OFF_GUZ), p.sgu_gain + (size_t)lj * 2048, p.sgu_b_s + ((size_t)lj * 8 + g) * 128, chunk * 128, c0};
    gemm_tile<1, 8>(xl, (const u16*)(p.ws + OFF_GVT) + ((size_t)chunk * 2048 + c0) * 128, 128, 128, ep, smem);
  }
}

struct XLerp {
  const u16* H; const float* mu; int m0;
  DI u32x4 operator()(int row, int k) const {
    const int grow = m0 + row;
    int pos, len; if (grow < T) { pos = grow & (SEQ - 1); len = SEQ; } else { pos = (grow - T) & (CTXL - 1); len = CTXL; }
    const u16* hp = H + (size_t)grow * D + k;
    const u32x4 c = *(const u32x4*)hp;
    u32x4 a = (u32x4){0u, 0u, 0u, 0u}, b = (u32x4){0u, 0u, 0u, 0u};
    if (pos > 0) a = *(const u32x4*)(hp - D);
    if (pos < len - 1) b = *(const u32x4*)(hp + D);
    const f32x4 m0v = *(const f32x4*)(mu + k), m1v = *(const f32x4*)(mu + k + 4);
    u32x4 o;
#pragma unroll
    for (int e = 0; e < 4; ++e) {
      const float c0 = bflo(c[e]), c1 = bfhi(c[e]);
      const float x0 = 0.5f * (bflo(a[e]) + bflo(b[e])) - c0, x1 = 0.5f * (bfhi(a[e]) + bfhi(b[e])) - c1;
      const float mu0 = e < 2 ? m0v[2 * e] : m1v[2 * e - 4], mu1 = e < 2 ? m0v[2 * e + 1] : m1v[2 * e - 3];
      o[e] = pack2bf(c0 + x0 * mu0, c1 + x1 * mu1);
    }
    return o;
  }
};
template <int NI>
struct EpiF16 {
  h16* O; int ld, m0, n0; bool tanh_;
  DI void operator()(const f32x16 (&acc)[NI], int w, int r, int h) const {
    h16* rowp = O + (size_t)(m0 + 32 * w + r) * ld + n0;
#pragma unroll
    for (int ni = 0; ni < NI; ++ni)
#pragma unroll
      for (int q = 0; q < 4; ++q) {
        h16x4 o;
#pragma unroll
        for (int e = 0; e < 4; ++e) { float v = acc[ni][4 * q + e]; if (tanh_) v = 2.0f * sigmoidf_(2.0f * v) - 1.0f; o[e] = (h16)v; }
        *(h16x4*)(rowp + 32 * ni + 8 * q + 4 * h) = o;
      }
  }
};
DI void phase_rwkv_g(const Params& p, char* smem) {
  const u16* H = (const u16*)(p.ws + OFF_H);
  const u16* W = (const u16*)(p.ws + OFF_W);
  for (int vb = blockIdx.x; (vb >> 3) < 1188; vb += gridDim.x) {
    const int xcd = vb & 7, lg = vb >> 3;
    if (lg < 1056) {
      const int mt = lg >> 1, jt = xcd + 8 * (lg & 1); const int c = jt >> 2, nt = jt & 3;
      XLerp xl{H, p.rwkv_mu + (size_t)c * 1024, mt * 128};
      EpiF16<8> ep{(h16*)(p.ws + OFF_R + (size_t)c * SZ_ACT), 1024, mt * 128, nt * 256, false};
      gemm_tile<1, 8>(xl, W + W_RIN + (size_t)c * 1024 * 1024 + (size_t)nt * 256 * 1024, 1024, 1024, ep, smem);
    } else {
      const int l2 = lg - 1056; const int mt = (l2 >> 1) * 8 + xcd, which = l2 & 1;
      XLerp xl{H, p.rwkv_mu + (size_t)(4 + which) * 1024, mt * 128};
      EpiF16<4> ep{(h16*)(p.ws + (which ? OFF_TA : OFF_TW)), 128, mt * 128, 0, which == 0};
      gemm_tile<1, 4>(xl, W + (which ? W_L1A : W_L1W), 1024, 1024, ep, smem);
    }
  }
}

DI int unit_row0(int u) { const int ch = u % 33, bh = u / 33, b = bh >> 4; return ch == 0 ? T + b * CTXL : b * SEQ + (ch - 1) * 256; }

template <bool PASS_C>
DI void phase_scan(const Params& p, char* smem) {
  const int tid = threadIdx.x, lane = tid & 63, w = tid >> 6, dir = w & 1;
  const bool isP = !PASS_C && (w >> 1);
  float* lb = (float*)(smem + w * 14336);
  float* kkb = lb, *rb = lb + 512, *wb = lb + 1024, *kab = lb + 1536, *kdb = lb + 2048, *vb = lb + 2560, *yob = lb + 3072;
  const h16* Rg = (const h16*)(p.ws + OFF_R); const h16* Kg = (const h16*)(p.ws + OFF_K); const h16* Vg = (const h16*)(p.ws + OFF_V);
  const h16* TWg = (const h16*)(p.ws + OFF_TW); const h16* TAg = (const h16*)(p.ws + OFF_TA);
  h16* Yg = (h16*)(p.ws + OFF_H);
  float* BSg = (float*)(p.ws + OFF_BS);
  h16* SUM = (h16*)(p.ws + OFF_SUMM);
  for (int up = blockIdx.x; up < (PASS_C ? NUNIT / 2 : NUNIT); up += gridDim.x) {
    const int u = PASS_C ? 2 * up + (w >> 1) : up;
    const int hd = (u / 33) & 15, ch = u % 33;
    const int row0 = unit_row0(u);
    const int col = hd * 64 + lane;
    const h16* W2Tw = (const h16*)((const u16*)(p.ws + OFF_W) + W_L2W) + (size_t)dir * 1024 * 64;
    const h16* W2Ta = (const h16*)((const u16*)(p.ws + OFF_W) + W_L2A) + (size_t)dir * 1024 * 64;
    f32x2 S[32];
#pragma unroll
    for (int q = 0; q < 32; ++q) S[q] = (f32x2){0.f, 0.f};
    if (PASS_C) {
      if (ch != 0) {
        const h16* sp = SUM + ((size_t)(u * 2 + dir) * 2 + 0) * 4096 + lane * 64;
#pragma unroll
        for (int q = 0; q < 8; ++q) { const h16x8 v = *(const h16x8*)(sp + 8 * q);
#pragma unroll
          for (int e = 0; e < 4; ++e) S[4 * q + e] = (f32x2){(float)v[2 * e], (float)v[2 * e + 1]}; }
      }
    } else {
#pragma unroll
      for (int q = 0; q < 32; ++q) { if (isP && lane == 2 * q) S[q][0] = 1.f; if (isP && lane == 2 * q + 1) S[q][1] = 1.f; }
    }
    for (int j = 0; j < 32; ++j) {
      const int sb = dir == 0 ? j : 31 - j;
      {
        const int col16 = lane & 15, quad = lane >> 4, ts = col16 & 7, eh = col16 >> 3;
        int w2off = (hd * 64 + col16) * 64 + 8 * quad; asm volatile("" : "+v"(w2off));
        const int tok = row0 + sb * 8 + (dir == 0 ? ts : 7 - ts);
        h16x8 bw[2], ba[2];
#pragma unroll
        for (int ks = 0; ks < 2; ++ks) { bw[ks] = *(const h16x8*)(TWg + (size_t)tok * 128 + dir * 64 + 32 * ks + 8 * quad); ba[ks] = *(const h16x8*)(TAg + (size_t)tok * 128 + dir * 64 + 32 * ks + 8 * quad); }
        f32x4 cw[4], ca[4];
#pragma unroll
        for (int et = 0; et < 4; ++et) {
          cw[et] = (f32x4){0.f, 0.f, 0.f, 0.f}; ca[et] = (f32x4){0.f, 0.f, 0.f, 0.f};
#pragma unroll
          for (int ks = 0; ks < 2; ++ks) {
            const h16x8 aw = *(const h16x8*)(W2Tw + w2off + et * 1024 + 32 * ks);
            const h16x8 aa = *(const h16x8*)(W2Ta + w2off + et * 1024 + 32 * ks);
            cw[et] = __builtin_amdgcn_mfma_f32_16x16x32_f16(aw, bw[ks], cw[et], 0, 0, 0);
            ca[et] = __builtin_amdgcn_mfma_f32_16x16x32_f16(aa, ba[ks], ca[et], 0, 0, 0);
          }
        }
        float ssq = 0.f, bsum = 0.f;
        f32x4 kkr[2], kdv[2], axv[2], decv[2], rxv[2], vxv[2], yov[2];
#pragma unroll
        for (int t = 0; t < 2; ++t) {
          const int e0 = (2 * eh + t) * 16 + 4 * quad; const int c0 = hd * 64 + e0;
          const f32x4 wl4 = eh ? cw[2 + t] : cw[t], al4 = eh ? ca[2 + t] : ca[t];
          const size_t gi = (size_t)tok * 1024 + c0;
          const h16x4 k4 = *(const h16x4*)(Kg + gi), r4 = *(const h16x4*)(Rg + gi), v4 = *(const h16x4*)(Vg + gi);
          h16x4 y4 = (h16x4){(h16)0.f, (h16)0.f, (h16)0.f, (h16)0.f};
          if (PASS_C) { if (j >= 16) y4 = *(const h16x4*)(Yg + gi); }
          const f32x4 w04 = *(const f32x4*)(p.rwkv_w0 + dir * 1024 + c0), a04 = *(const f32x4*)(p.rwkv_a0 + dir * 1024 + c0);
          const f32x4 kk4 = *(const f32x4*)(p.rwkv_k_k + c0), ka4 = *(const f32x4*)(p.rwkv_k_a + c0), rk4 = *(const f32x4*)(p.rwkv_r_k + c0);
#pragma unroll
          for (int e = 0; e < 4; ++e) {
            const float kx = (float)k4[e], rx = (float)r4[e];
            const float kr = kx * kk4[e]; ssq += kr * kr; kkr[t][e] = kr;
            const float nx = -(wl4[e] + w04[e]); const float sp = fmaxf(nx, 0.f) + __logf(1.0f + __expf(-fabsf(nx)));
            decv[t][e] = __expf(-__expf(-sp - 0.5f));
            const float ax = sigmoidf_(al4[e] + a04[e]); axv[t][e] = ax;
            const float kd = kx * (1.0f + (ax - 1.0f) * ka4[e]); kdv[t][e] = kd;
            bsum += rx * kd * rk4[e]; rxv[t][e] = rx; vxv[t][e] = (float)v4[e]; yov[t][e] = (float)y4[e];
          }
        }
        ssq += __shfl_xor(ssq, 8); ssq += __shfl_xor(ssq, 16); ssq += __shfl_xor(ssq, 32);
        const float rn = rsqrtf(ssq + 1e-12f);
#pragma unroll
        for (int t = 0; t < 2; ++t) {
          const int e0 = (2 * eh + t) * 16 + 4 * quad; const int li = ts * 64 + e0;
          const f32x4 kkn = kkr[t] * rn;
          *(f32x4*)(kkb + li) = kkn; *(f32x4*)(rb + li) = rxv[t]; *(f32x4*)(wb + li) = decv[t]; *(f32x4*)(kab + li) = kkn * axv[t]; *(f32x4*)(kdb + li) = kdv[t]; *(f32x4*)(vb + li) = vxv[t];
          if (PASS_C) *(f32x4*)(yob + li) = yov[t];
        }
        if (PASS_C) {
          bsum += __shfl_xor(bsum, 8); bsum += __shfl_xor(bsum, 16); bsum += __shfl_xor(bsum, 32);
          if (lane < 8) BSg[((size_t)tok * 16 + hd) * 2 + dir] = bsum;
        }
      }
      __builtin_amdgcn_s_waitcnt(0xc07f);
#ifndef NO_STEP
#pragma unroll 1
      for (int s = 0; s < 8; ++s) {
        const f32x4* kk4 = (const f32x4*)(kkb + s * 64);
        f32x2 d0 = (f32x2){0.f, 0.f}, d1 = (f32x2){0.f, 0.f};
#pragma unroll
        for (int q = 0; q < 16; ++q) {
          const f32x4 k4 = kk4[q]; const f32x2 klo = (f32x2){k4[0], k4[1]}, khi = (f32x2){k4[2], k4[3]};
          d0 = __builtin_elementwise_fma(S[2 * q], klo, d0); d1 = __builtin_elementwise_fma(S[2 * q + 1], khi, d1);
          if ((q & 3) == 3) __builtin_amdgcn_sched_barrier(0);
        }
        const float a2 = -((d0[0] + d0[1]) + (d1[0] + d1[1]));
        const float a1 = isP ? 0.f : vb[s * 64 + lane];
        const f32x2 a1v = (f32x2){a1, a1}, a2v = (f32x2){a2, a2};
        const f32x4* w4p = (const f32x4*)(wb + s * 64); const f32x4* ka4p = (const f32x4*)(kab + s * 64);
        const f32x4* kd4p = (const f32x4*)(kdb + s * 64); const f32x4* r4p = (const f32x4*)(rb + s * 64);
        f32x2 y0 = (f32x2){0.f, 0.f}, y1 = (f32x2){0.f, 0.f};
#pragma unroll
        for (int q = 0; q < 16; ++q) {
          const f32x4 w4 = w4p[q], ka4 = ka4p[q], kd4 = kd4p[q];
          const f32x2 wlo = (f32x2){w4[0], w4[1]}, whi = (f32x2){w4[2], w4[3]};
          const f32x2 kalo = (f32x2){ka4[0], ka4[1]}, kahi = (f32x2){ka4[2], ka4[3]};
          const f32x2 kdlo = (f32x2){kd4[0], kd4[1]}, kdhi = (f32x2){kd4[2], kd4[3]};
          f32x2 t0 = a1v * kdlo, t1 = a1v * kdhi;
          t0 = __builtin_elementwise_fma(a2v, kalo, t0); t1 = __builtin_elementwise_fma(a2v, kahi, t1);
          S[2 * q] = __builtin_elementwise_fma(S[2 * q], wlo, t0); S[2 * q + 1] = __builtin_elementwise_fma(S[2 * q + 1], whi, t1);
          if (PASS_C) {
            const f32x4 r4 = r4p[q];
            y0 = __builtin_elementwise_fma(S[2 * q], (f32x2){r4[0], r4[1]}, y0); y1 = __builtin_elementwise_fma(S[2 * q + 1], (f32x2){r4[2], r4[3]}, y1);
          }
          if ((q & 1) == 1) __builtin_amdgcn_sched_barrier(0);
        }
        if (PASS_C) {
          float y = (y0[0] + y0[1]) + (y1[0] + y1[1]);
          const int tok = row0 + sb * 8 + (dir == 0 ? s : 7 - s);
          y += yob[s * 64 + lane];
          Yg[(size_t)tok * 1024 + col] = (h16)y;
        }
      }
#endif
      __syncthreads();
    }
    if (!PASS_C) {
      h16* sp = SUM + ((size_t)(u * 2 + dir) * 2 + (isP ? 1 : 0)) * 4096 + lane * 64;
#pragma unroll
      for (int q = 0; q < 8; ++q) {
        h16x8 sv;
#pragma unroll
        for (int e = 0; e < 4; ++e) { sv[2 * e] = (h16)S[4 * q + e][0]; sv[2 * e + 1] = (h16)S[4 * q + e][1]; }
        *(h16x8*)(sp + 8 * q) = sv;
      }
    }
  }
}


DI float dpp_add(float x, const int ctrl_sel) {
  int xi = __builtin_bit_cast(int, x); int yi;
  if (ctrl_sel == 0) yi = __builtin_amdgcn_mov_dpp(xi, 0xB1, 0xf, 0xf, true);
  else if (ctrl_sel == 1) yi = __builtin_amdgcn_mov_dpp(xi, 0x4E, 0xf, 0xf, true);
  else yi = __builtin_amdgcn_mov_dpp(xi, 0x141, 0xf, 0xf, true);
  return x + __builtin_bit_cast(float, yi);
}
DI float red8(float x) { x = dpp_add(x, 0); x = dpp_add(x, 1); x = dpp_add(x, 2); return x; }

struct ScanPre { h16x8 bw[2], ba[2]; h16x4 k4, r4, v4; };

DI void phase_scan_seq(const Params& p, char* smem) {
  int tid_ = threadIdx.x; asm volatile("" : "+v"(tid_));
  const int tid = tid_, lane = tid & 63, w = tid >> 6;
  float* fb = (float*)smem;
  float* part = fb + 2 * 6144;
  float* partb = part + 128;
  float* ybuf = partb + 128;
  const h16* Rg = (const h16*)(p.ws + OFF_R); const h16* Kg = (const h16*)(p.ws + OFF_K); const h16* Vg = (const h16*)(p.ws + OFF_V);
  const h16* TWg = (const h16*)(p.ws + OFF_TW); const h16* TAg = (const h16*)(p.ws + OFF_TA);
  float* BSg = (float*)(p.ws + OFF_BS);
  const int ts = lane & 15, quad = lane >> 4;
  const int rowl = w * 16 + (lane >> 2), kq = lane & 3;
  constexpr int NST = 528;
  for (int u = blockIdx.x; u < 256; u += gridDim.x) {
    const int chain = u, dir = chain & 1, bh = chain >> 1, b = bh >> 4, hd = bh & 15;
    h16* Yg = (h16*)(p.ws + (dir == 0 ? OFF_H : OFF_Y1));
    const int e0 = 16 * w + 4 * quad;
    const int c0 = hd * 64 + e0;
    h16x8 aw[2], aa[2];
    {
      const h16* W2Tw = (const h16*)((const u16*)(p.ws + OFF_W) + W_L2W) + (size_t)dir * 1024 * 64 + (size_t)(hd * 64 + 16 * w + ts) * 64 + 8 * quad;
      const h16* W2Ta = (const h16*)((const u16*)(p.ws + OFF_W) + W_L2A) + (size_t)dir * 1024 * 64 + (size_t)(hd * 64 + 16 * w + ts) * 64 + 8 * quad;
      aw[0] = *(const h16x8*)W2Tw; aw[1] = *(const h16x8*)(W2Tw + 32); aa[0] = *(const h16x8*)W2Ta; aa[1] = *(const h16x8*)(W2Ta + 32);
    }
    const f32x4 w0c = *(const f32x4*)(p.rwkv_w0 + dir * 1024 + c0), a0c = *(const f32x4*)(p.rwkv_a0 + dir * 1024 + c0);
    const f32x4 kkc = *(const f32x4*)(p.rwkv_k_k + c0), kac = *(const f32x4*)(p.rwkv_k_a + c0), rkc = *(const f32x4*)(p.rwkv_r_k + c0);
    auto stage_row = [&](int st) -> int {
      if (st < 16) return T + b * CTXL + (dir == 0 ? st : 15 - st) * 16;
      const int q = st - 16; return b * SEQ + (dir == 0 ? q : 511 - q) * 16;
    };
    auto pre_load = [&](int st) -> ScanPre {
      ScanPre pr; const int tok = stage_row(st) + (dir == 0 ? ts : 15 - ts);
      const h16* twp = TWg + (size_t)tok * 128 + dir * 64 + 8 * quad; const h16* tap = TAg + (size_t)tok * 128 + dir * 64 + 8 * quad;
      pr.bw[0] = *(const h16x8*)twp; pr.bw[1] = *(const h16x8*)(twp + 32); pr.ba[0] = *(const h16x8*)tap; pr.ba[1] = *(const h16x8*)(tap + 32);
      const size_t gi = (size_t)tok * 1024 + c0;
      pr.k4 = *(const h16x4*)(Kg + gi); pr.r4 = *(const h16x4*)(Rg + gi); pr.v4 = *(const h16x4*)(Vg + gi);
      return pr;
    };
    auto pre_compute = [&](const ScanPre& pr, int buf) {
      f32x4 cw = (f32x4){0.f, 0.f, 0.f, 0.f}, ca = (f32x4){0.f, 0.f, 0.f, 0.f};
#pragma unroll
      for (int ks = 0; ks < 2; ++ks) { cw = __builtin_amdgcn_mfma_f32_16x16x32_f16(aw[ks], pr.bw[ks], cw, 0, 0, 0); ca = __builtin_amdgcn_mfma_f32_16x16x32_f16(aa[ks], pr.ba[ks], ca, 0, 0, 0); }
      float* B = fb + buf * 6144 + ts * 64 + e0;
      f32x4 kkr, rx, vx, dec, kar, kd; float ssq = 0.f, bsum = 0.f;
#pragma unroll
      for (int e = 0; e < 4; ++e) {
        const float wl = cw[e] + w0c[e], al = ca[e] + a0c[e];
        const float kx = (float)pr.k4[e]; rx[e] = (float)pr.r4[e]; vx[e] = (float)pr.v4[e];
        const float kr = kx * kkc[e]; kkr[e] = kr; ssq += kr * kr;
        const float nx = -wl; const float sp = fmaxf(nx, 0.f) + __logf(1.0f + __expf(-fabsf(nx)));
        dec[e] = __expf(-__expf(-sp - 0.5f));
        const float ax = sigmoidf_(al);
        kd[e] = kx * (1.0f + (ax - 1.0f) * kac[e]); kar[e] = kr * ax;
        bsum += rx[e] * kd[e] * rkc[e];
      }
      *(f32x4*)(B) = kkr; *(f32x4*)(B + 1024) = rx; *(f32x4*)(B + 2048) = dec; *(f32x4*)(B + 3072) = kar; *(f32x4*)(B + 4096) = kd; *(f32x4*)(B + 5120) = vx;
      ssq += __shfl_xor(ssq, 16); ssq += __shfl_xor(ssq, 32);
      bsum += __shfl_xor(bsum, 16); bsum += __shfl_xor(bsum, 32);
      if (lane < 16) { part[(buf * 16 + ts) * 4 + w] = ssq; partb[(buf * 16 + ts) * 4 + w] = bsum; }
    };
    f32x2 S[8];
#pragma unroll
    for (int i = 0; i < 8; ++i) S[i] = (f32x2){0.f, 0.f};
    __syncthreads();
    { const ScanPre pr = pre_load(0); pre_compute(pr, 0); }
    __syncthreads();
#pragma unroll 1
    for (int st = 0; st < NST; ++st) {
      const int cur = st & 1;
      ScanPre pr; const bool more = st + 1 < NST;
      if (more) pr = pre_load(st + 1);
      if (tid < 16) {
        const f32x4 pb = *(const f32x4*)(partb + (cur * 16 + tid) * 4);
        const int tok = stage_row(st) + (dir == 0 ? tid : 15 - tid);
        BSg[((size_t)tok * 16 + hd) * 2 + dir] = (pb[0] + pb[1]) + (pb[2] + pb[3]);
      }
      const float* B = fb + cur * 6144;
      float* yb = ybuf + cur * 1024;
#pragma unroll 8
      for (int s = 0; s < 16; ++s) {
        const float* Bs = B + s * 64 + 16 * kq;
        f32x4 kk[4], ww[4], ka[4], kd[4], rr[4];
#pragma unroll
        for (int q = 0; q < 4; ++q) { kk[q] = *(const f32x4*)(Bs + 4 * q); ww[q] = *(const f32x4*)(Bs + 2048 + 4 * q); ka[q] = *(const f32x4*)(Bs + 3072 + 4 * q); kd[q] = *(const f32x4*)(Bs + 4096 + 4 * q); rr[q] = *(const f32x4*)(Bs + 1024 + 4 * q); }
        const f32x4 pr4 = *(const f32x4*)(part + (cur * 16 + s) * 4);
        const float a1 = B[5120 + s * 64 + rowl];
        f32x2 d0 = S[0] * (f32x2){kk[0][0], kk[0][1]}, d1 = S[1] * (f32x2){kk[0][2], kk[0][3]};
#pragma unroll
        for (int q = 1; q < 4; ++q) { d0 = __builtin_elementwise_fma(S[2 * q], (f32x2){kk[q][0], kk[q][1]}, d0); d1 = __builtin_elementwise_fma(S[2 * q + 1], (f32x2){kk[q][2], kk[q][3]}, d1); }
        float x = (d0[0] + d0[1]) + (d1[0] + d1[1]); x = dpp_add(x, 0); x = dpp_add(x, 1);
        const float rn2 = __builtin_amdgcn_rcpf((pr4[0] + pr4[1]) + (pr4[2] + pr4[3]) + 1e-12f);
        const float a2 = -x * rn2;
        const f32x2 a1v = (f32x2){a1, a1}, a2v = (f32x2){a2, a2};
        f32x2 y0 = (f32x2){0.f, 0.f}, y1 = (f32x2){0.f, 0.f};
#pragma unroll
        for (int q = 0; q < 4; ++q) {
          f32x2 t0 = __builtin_elementwise_fma(a2v, (f32x2){ka[q][0], ka[q][1]}, a1v * (f32x2){kd[q][0], kd[q][1]});
          f32x2 t1 = __builtin_elementwise_fma(a2v, (f32x2){ka[q][2], ka[q][3]}, a1v * (f32x2){kd[q][2], kd[q][3]});
          S[2 * q] = __builtin_elementwise_fma(S[2 * q], (f32x2){ww[q][0], ww[q][1]}, t0);
          S[2 * q + 1] = __builtin_elementwise_fma(S[2 * q + 1], (f32x2){ww[q][2], ww[q][3]}, t1);
          y0 = __builtin_elementwise_fma(S[2 * q], (f32x2){rr[q][0], rr[q][1]}, y0);
          y1 = __builtin_elementwise_fma(S[2 * q + 1], (f32x2){rr[q][2], rr[q][3]}, y1);
        }
        float y = (y0[0] + y0[1]) + (y1[0] + y1[1]); y = dpp_add(y, 0); y = dpp_add(y, 1);
        if (kq == 0) yb[s * 64 + rowl] = y;
      }
      if (more) pre_compute(pr, cur ^ 1);
      __syncthreads();
#pragma unroll
      for (int hh = 0; hh < 4; ++hh) { const int s = (tid >> 6) + 4 * hh, vl = tid & 63; const int tok = stage_row(st) + (dir == 0 ? s : 15 - s);
        Yg[(size_t)tok * 1024 + hd * 64 + vl] = (h16)yb[s * 64 + vl]; }
    }
    __syncthreads();
  }
}

DI void phase_combine(const Params& p, char* smem) {
  const int tid = threadIdx.x, v = tid >> 2, kq = tid & 3;
  float* curs = (float*)smem;
  float* Ps = (float*)(smem + 64 * 68 * 4);
  h16* SUM = (h16*)(p.ws + OFF_SUMM);
  for (int cidx = blockIdx.x; cidx < 256; cidx += gridDim.x) {
    const int dir = cidx & 1, bh = cidx >> 1;
    float cur[16];
#pragma unroll
    for (int e = 0; e < 16; ++e) cur[e] = 0.f;
    for (int i = 0; i < 33; ++i) {
      const int ch = i == 0 ? 0 : (dir == 0 ? i : 33 - i);
      const int u = bh * 33 + ch;
      h16* sp = SUM + ((size_t)(u * 2 + dir) * 2) * 4096;
      const h16x8 se0 = *(const h16x8*)(sp + v * 64 + kq * 16), se1 = *(const h16x8*)(sp + v * 64 + kq * 16 + 8);
      const h16x8 pe0 = *(const h16x8*)(sp + 4096 + v * 64 + kq * 16), pe1 = *(const h16x8*)(sp + 4096 + v * 64 + kq * 16 + 8);
      __syncthreads();
      h16x8 c0, c1;
#pragma unroll
      for (int e = 0; e < 8; ++e) { c0[e] = (h16)cur[e]; c1[e] = (h16)cur[8 + e]; curs[v * 68 + kq * 16 + e] = cur[e]; curs[v * 68 + kq * 16 + 8 + e] = cur[8 + e];
        Ps[v * 64 + kq * 16 + e] = (float)pe0[e]; Ps[v * 64 + kq * 16 + 8 + e] = (float)pe1[e]; }
      *(h16x8*)(sp + v * 64 + kq * 16) = c0; *(h16x8*)(sp + v * 64 + kq * 16 + 8) = c1;
      __syncthreads();
      float nw[16];
#pragma unroll
      for (int e = 0; e < 8; ++e) { nw[e] = (float)se0[e]; nw[8 + e] = (float)se1[e]; }
      for (int jj = 0; jj < 64; jj += 4) {
        const f32x4 cv = *(const f32x4*)(curs + v * 68 + jj);
#pragma unroll
        for (int e4 = 0; e4 < 4; ++e4) {
          const float cs = cv[e4];
#pragma unroll
          for (int q = 0; q < 4; ++q) { const f32x4 pv = *(const f32x4*)(Ps + (jj + e4) * 64 + kq * 16 + 4 * q);
#pragma unroll
            for (int e = 0; e < 4; ++e) nw[4 * q + e] += cs * pv[e]; }
        }
      }
#pragma unroll
      for (int e = 0; e < 16; ++e) cur[e] = nw[e];
    }
    __syncthreads();
  }
}

DI void phase_rwkv_ln(const Params& p) {
  const int lane = threadIdx.x & 63, w = threadIdx.x >> 6, hd = lane >> 2;
  const h16* Yg = (const h16*)(p.ws + OFF_H); const h16* Y1g = (const h16*)(p.ws + OFF_Y1); const h16* Vg = (const h16*)(p.ws + OFF_V);
  h16* Zg = (h16*)(p.ws + OFF_Z); const float* BSg = (const float*)(p.ws + OFF_BS);
  const int c0 = lane * 16;
  for (int row = blockIdx.x * 4 + w; row < MALL; row += gridDim.x * 4) {
    const size_t gi = (size_t)row * 1024 + c0;
    float y[16], vv[16], zz[16];
#pragma unroll
    for (int q = 0; q < 2; ++q) { const h16x8 a = *(const h16x8*)(Yg + gi + 8 * q), a1 = *(const h16x8*)(Y1g + gi + 8 * q), b = *(const h16x8*)(Vg + gi + 8 * q), c = *(const h16x8*)(Zg + gi + 8 * q);
#pragma unroll
      for (int e = 0; e < 8; ++e) { y[8 * q + e] = (float)a[e] + (float)a1[e]; vv[8 * q + e] = (float)b[e]; zz[8 * q + e] = (float)c[e]; } }
    float s = 0.f;
#pragma unroll
    for (int e = 0; e < 16; ++e) s += y[e];
    s += __shfl_xor(s, 1); s += __shfl_xor(s, 2);
    const float mean = s * (1.0f / 64.0f);
    float q2 = 0.f;
#pragma unroll
    for (int e = 0; e < 16; ++e) { const float d = y[e] - mean; q2 += d * d; }
    q2 += __shfl_xor(q2, 1); q2 += __shfl_xor(q2, 2);
    const float rstd = rsqrtf(q2 * (1.0f / 64.0f) + 64e-5f);
    const float bon = BSg[((size_t)row * 16 + hd) * 2] + BSg[((size_t)row * 16 + hd) * 2 + 1];
    unsigned o[8];
#pragma unroll
    for (int e = 0; e < 8; ++e) {
      float t0 = (y[2 * e] - mean) * rstd * p.rwkv_ln_gain[c0 + 2 * e] + p.rwkv_ln_bias[c0 + 2 * e] + bon * vv[2 * e];
      float t1 = (y[2 * e + 1] - mean) * rstd * p.rwkv_ln_gain[c0 + 2 * e + 1] + p.rwkv_ln_bias[c0 + 2 * e + 1] + bon * vv[2 * e + 1];
      o[e] = pack2bf(t0 * siluf_(zz[2 * e]), t1 * siluf_(zz[2 * e + 1]));
    }
    u32x4* op = (u32x4*)(Zg + gi);
    op[0] = (u32x4){o[0], o[1], o[2], o[3]}; op[1] = (u32x4){o[4], o[5], o[6], o[7]};
  }
}

struct EpiMlaIn {
  const Params* p; int m0, nt;
  DI void operator()(const f32x16 (&acc)[4], int w, int r, int h) const {
    const int row = m0 + 32 * w + r;
    if (nt < 8) {
      float ss = 0.f;
      u16* O = nt < 6 ? (u16*)(p->ws + OFF_CQ) + (size_t)row * 768 + nt * 128 : (u16*)(p->ws + OFF_CKV) + (size_t)row * 256 + (nt - 6) * 128;
#pragma unroll
      for (int ni = 0; ni < 4; ++ni)
#pragma unroll
        for (int q = 0; q < 4; ++q) {
          const float a0 = acc[ni][4 * q], a1 = acc[ni][4 * q + 1], a2 = acc[ni][4 * q + 2], a3 = acc[ni][4 * q + 3];
          ss += a0 * a0 + a1 * a1 + a2 * a2 + a3 * a3;
          *(u32x2*)(O + 32 * ni + 8 * q + 4 * h) = (u32x2){pack2bf(a0, a1), pack2bf(a2, a3)};
        }
      ss += __shfl_xor(ss, 32);
      if (h == 0) atomicAdd((float*)(p->ws + (nt < 6 ? OFF_SSQA : OFF_SSQB)) + row, ss);
    } else if (nt < 24) {
      u16* O = (u16*)(p->ws + OFF_SZ) + (size_t)row * 2048 + (nt - 8) * 128;
#pragma unroll
      for (int ni = 0; ni < 4; ++ni)
#pragma unroll
        for (int q = 0; q < 4; ++q)
          *(u32x2*)(O + 32 * ni + 8 * q + 4 * h) = (u32x2){pack2bf(siluf_(acc[ni][4 * q]), siluf_(acc[ni][4 * q + 1])), pack2bf(siluf_(acc[ni][4 * q + 2]), siluf_(acc[ni][4 * q + 3]))};
    } else {
      float* O = (float*)(p->ws + OFF_KR) + (size_t)row * 64; float ss = 0.f;
#pragma unroll
      for (int ni = 0; ni < 2; ++ni)
#pragma unroll
        for (int q = 0; q < 4; ++q) {
          f32x4 o;
#pragma unroll
          for (int e = 0; e < 4; ++e) { o[e] = acc[ni][4 * q + e]; ss += o[e] * o[e]; }
          *(f32x4*)(O + 32 * ni + 8 * q + 4 * h) = o;
        }
      ss += __shfl_xor(ss, 32);
      if (h == 0) ((float*)(p->ws + OFF_SSQR))[row] = ss;
    }
  }
};
DI void phase_mla_in(const Params& p, char* smem) {
  const u16* H = (const u16*)(p.ws + OFF_H);
  const u16* Wt = (const u16*)(p.ws + OFF_W) + W_MIN;
  for (int vb = blockIdx.x; (vb >> 3) < 803; vb += gridDim.x) {
    const int xcd = vb & 7, lg = vb >> 3;
    int mt, nt;
    if (lg < 768) { mt = lg / 3; nt = xcd + 8 * (lg % 3); }
    else if (lg < 800) { mt = (lg - 768) * 8 + xcd; nt = 24; }
    else { const int q = (lg - 800) * 8 + xcd; mt = 256 + q / 3; const int s = q % 3; nt = s == 0 ? 6 : (s == 1 ? 7 : 24); }
    EpiMlaIn ep{&p, mt * 256, nt};
    gemm_tile_glds(H + (size_t)mt * 256 * D, D, Wt + (size_t)nt * 128 * D, D, D, ep, smem);
  }
}

constexpr float QSCALE = 0.07216878364870322f * 1.4426950408889634f;
struct EpiMlaQ {
  const Params* p; int grow0  , lrow0  , head;
  DI void operator()(const f32x16 (&acc)[6], int w, int r, int h) const {
    const int row = grow0 + 32 * w + r, lrow = lrow0 + 32 * w + r;
    const float rq = rsqrtf(((const float*)(p->ws + OFF_SSQA))[row] * (1.0f / 768.0f) + 1e-6f);
    float ss = 0.f;
#pragma unroll
    for (int ni = 0; ni < 6; ++ni)
#pragma unroll
      for (int i = 0; i < 16; ++i) { const float v = acc[ni][i] * rq; ss += v * v; }
    ss += __shfl_xor(ss, 32);
    const float sc = rq * rsqrtf(ss * (1.0f / 192.0f) + 1e-6f) * QSCALE;
    const float* gq = p->mla_qk_gain_q;
    u16* O = (u16*)(p->ws + OFF_QX) + ((size_t)lrow * 16 + head) * 256;
#pragma unroll
    for (int ni = 0; ni < 4; ++ni)
#pragma unroll
      for (int q = 0; q < 4; ++q) {
        const int n = 32 * ni + 8 * q + 4 * h; const f32x4 g = *(const f32x4*)(gq + n);
        *(u32x2*)(O + n) = (u32x2){pack2bf(acc[ni][4 * q] * sc * g[0], acc[ni][4 * q + 1] * sc * g[1]), pack2bf(acc[ni][4 * q + 2] * sc * g[2], acc[ni][4 * q + 3] * sc * g[3])};
      }
    const int pos = row & (SEQ - 1); const int prow = pos >> 6, pcol = pos & 63;
    const f32x2* cs = (const f32x2*)(p->ws + OFF_CS);
#pragma unroll
    for (int q = 0; q < 4; ++q) {
      const int pb = 8 * q + 4 * h;
      float x1[4], x2[4], o1[4], o2[4];
#pragma unroll
      for (int e = 0; e < 4; ++e) {
        const int pi = pb + e;
        x1[e] = acc[4][4 * q + e] * sc * gq[128 + pi]; x2[e] = acc[5][4 * q + e] * sc * gq[160 + pi];
        const f32x2 c = pi < 16 ? cs[prow * 16 + pi] : cs[2048 + pcol * 16 + (pi - 16)];
        o1[e] = x1[e] * c[0] - x2[e] * c[1]; o2[e] = x1[e] * c[1] + x2[e] * c[0];
      }
      *(u32x2*)(O + 128 + pb) = (u32x2){pack2bf(o1[0], o1[1]), pack2bf(o1[2], o1[3])};
      *(u32x2*)(O + 160 + pb) = (u32x2){pack2bf(o2[0], o2[1]), pack2bf(o2[2], o2[3])};
      *(u32x2*)(O + 192 + pb) = (u32x2){pack2bf(x1[0], x1[1]), pack2bf(x1[2], x1[3])};
      *(u32x2*)(O + 224 + pb) = (u32x2){pack2bf(x2[0], x2[1]), pack2bf(x2[2], x2[3])};
    }
  }
};
struct EpiMlaKV {
  const Params* p; int grow0, kvrow0  , head, isv, blocal;
  DI void operator()(const f32x16 (&acc)[4], int w, int r, int h) const {
    const int row = grow0 + 32 * w + r, kvrow = kvrow0 + 32 * w + r;
    const float rkv = rsqrtf(((const float*)(p->ws + OFF_SSQB))[row] * (1.0f / 256.0f) + 1e-6f);
    if (isv) {
      u16* O = (u16*)(p->ws + OFF_VT) + ((size_t)(blocal * 16 + head) * 128) * 8448 + (kvrow - blocal * 8448);
#pragma unroll
      for (int ni = 0; ni < 4; ++ni)
#pragma unroll
        for (int i = 0; i < 16; ++i) O[(size_t)(32 * ni + crow(i, h)) * 8448] = f2bf(acc[ni][i] * rkv);
      return;
    }
    float ss = 0.f;
#pragma unroll
    for (int ni = 0; ni < 4; ++ni)
#pragma unroll
      for (int i = 0; i < 16; ++i) { const float v = acc[ni][i] * rkv; ss += v * v; }
    ss += __shfl_xor(ss, 32);
    ss += ((const float*)(p->ws + OFF_SSQR))[row];
    const float rn = rsqrtf(ss * (1.0f / 192.0f) + 1e-6f); const float sc = rkv * rn;
    const float* gk = p->mla_qk_gain_k;
    u16* O = (u16*)(p->ws + OFF_KX) + ((size_t)kvrow * 16 + head) * 192;
#pragma unroll
    for (int ni = 0; ni < 4; ++ni)
#pragma unroll
      for (int q = 0; q < 4; ++q) {
        const int n = 32 * ni + 8 * q + 4 * h; const f32x4 g = *(const f32x4*)(gk + n);
        *(u32x2*)(O + n) = (u32x2){pack2bf(acc[ni][4 * q] * sc * g[0], acc[ni][4 * q + 1] * sc * g[1]), pack2bf(acc[ni][4 * q + 2] * sc * g[2], acc[ni][4 * q + 3] * sc * g[3])};
      }
    const float* kr = (const float*)(p->ws + OFF_KR) + (size_t)row * 64;
    const bool lat = row < T; const int pos = row & (SEQ - 1);
    const f32x2* cs = (const f32x2*)(p->ws + OFF_CS) + (h == 0 ? (pos >> 6) * 16 : 2048 + (pos & 63) * 16);
    unsigned o1[8], o2[8];
#pragma unroll
    for (int e = 0; e < 8; ++e) {
      float a[2], b[2];
#pragma unroll
      for (int t = 0; t < 2; ++t) {
        const int pi = 16 * h + 2 * e + t;
        const float x1 = kr[pi] * rn * gk[128 + pi], x2 = kr[32 + pi] * rn * gk[160 + pi];
        f32x2 c = (f32x2){1.f, 0.f}; if (lat) c = cs[2 * e + t];
        a[t] = x1 * c[0] - x2 * c[1]; b[t] = x1 * c[1] + x2 * c[0];
      }
      o1[e] = pack2bf(a[0], a[1]); o2[e] = pack2bf(b[0], b[1]);
    }
    u32x4* d1 = (u32x4*)(O + 128 + 16 * h); u32x4* d2 = (u32x4*)(O + 160 + 16 * h);
    d1[0] = (u32x4){o1[0], o1[1], o1[2], o1[3]}; d1[1] = (u32x4){o1[4], o1[5], o1[6], o1[7]};
    d2[0] = (u32x4){o2[0], o2[1], o2[2], o2[3]}; d2[1] = (u32x4){o2[4], o2[5], o2[6], o2[7]};
  }
};
struct EpiMlaKV8 {
  EpiMlaKV k, v;
  DI void operator()(const f32x16 (&acc)[8], int w, int r, int h) const {
    v(reinterpret_cast<const f32x16 (&)[4]>(acc[4]), w, r, h);
    __builtin_amdgcn_sched_barrier(0);
    k(reinterpret_cast<const f32x16 (&)[4]>(acc[0]), w, r, h);
  }
};
DI void phase_mla_up(const Params& p, int g, char* smem) {
  const u16* W = (const u16*)(p.ws + OFF_W);
  const int nq = 128 * 16, nkv = 132 * 16;
  for (int t = blockIdx.x; t < nq + nkv; t += gridDim.x) {
    if (t < nq) {
      const int mt = t >> 4, head = t & 15;
      const int grow0 = g * 16384 + mt * 128;
      XPlain xl{(const u16*)(p.ws + OFF_CQ) + (size_t)grow0 * 768, 768};
      EpiMlaQ ep{&p, grow0, mt * 128, head};
      gemm_tile<1, 6>(xl, W + W_UQ + (size_t)head * 192 * 768, 768, 768, ep, smem);
    } else {
      const int q = t - nq; const int mt = q >> 4, head = q & 15;
      int grow0, kvrow0, blocal;
      if (mt < 128) { blocal = mt >> 6; grow0 = g * 16384 + mt * 128; kvrow0 = blocal * 8448 + 256 + (mt & 63) * 128; }
      else { const int cm = mt - 128; blocal = cm >> 1; grow0 = T + (g * 2 + blocal) * 256 + (cm & 1) * 128; kvrow0 = blocal * 8448 + (cm & 1) * 128; }
      XPlain xl{(const u16*)(p.ws + OFF_CKV) + (size_t)grow0 * 256, 256};
      EpiMlaKV8 ep{EpiMlaKV{&p, grow0, kvrow0, head, 0, blocal}, EpiMlaKV{&p, grow0, kvrow0, head, 1, blocal}};
      gemm_tile<1, 8>(xl, W + W_UKV + (size_t)head * 256 * 256, 256, 256, ep, smem);
    }
  }
}

DI int kswap(int r) { return (r & ~12) | ((r & 4) << 1) | ((r & 8) >> 1); }
constexpr int KROW = 400;
DI void phase_attn(const Params& p, int g, char* smem, bool dry = false) {
  int tid_ = threadIdx.x; asm volatile("" : "+v"(tid_));
  const int tid = tid_, lane = tid & 63, w = tid >> 6, r = lane & 31, h = lane >> 5;
  char* Ks = smem; char* Vs = smem + 64 * KROW;
  const u16* QX = (const u16*)(p.ws + OFF_QX); const u16* KX = (const u16*)(p.ws + OFF_KX); const u16* VT = (const u16*)(p.ws + OFF_VT);
  u16* SZ = (u16*)(p.ws + OFF_SZ);
  const int ksr = kswap(r);
  for (int uu = blockIdx.x; uu < 2048; uu += gridDim.x) {
    const int xcd = uu & 7, lg = uu >> 3; const int bh = (lg >> 6) * 8 + xcd;
    const int qb = lg & 63, head = bh & 15, blocal = bh >> 4;
    const int lq = blocal * 8192 + qb * 128 + 32 * w + r;
    const u16* qp = QX + ((size_t)lq * 16 + head) * 256;
    bf16x8 qf[12];
#pragma unroll
    for (int ds = 0; ds < 8; ++ds) qf[ds] = *(const bf16x8*)(qp + 16 * ds + 8 * h);
#pragma unroll
    for (int ds = 0; ds < 4; ++ds) qf[8 + ds] = *(const bf16x8*)(qp + 192 + 16 * ds + 8 * h);
    f32x16 O[4];
#pragma unroll
    for (int di = 0; di < 4; ++di)
#pragma unroll
      for (int i = 0; i < 16; ++i) O[di][i] = 0.f;
    float m = -1e30f, l = 0.f;
    const u16* kbase = KX + ((size_t)blocal * 8448 * 16 + head) * 192;
    const u16* vbase = VT + (size_t)(blocal * 16 + head) * 128 * 8448;
    u32x4 kr_[6], vr_[4];
    const u16* kptr = kbase + (size_t)(tid >> 2) * 3072 + (tid & 3) * 8;
    const u16* vptr = vbase + (size_t)(tid >> 1) * 8448 + (tid & 1) * 32;
    char* kls = Ks + (tid >> 2) * KROW + (tid & 3) * 16;
    char* vls = Vs + (tid >> 1) * LROW + (tid & 1) * 64;
#pragma unroll
    for (int j = 0; j < 6; ++j) kr_[j] = *(const u32x4*)(kptr + 32 * j);
#pragma unroll
    for (int j = 0; j < 4; ++j) vr_[j] = *(const u32x4*)(vptr + 8 * j);
#pragma unroll 1
    for (int kt = 0; kt < 132; ++kt) {
      __syncthreads();
#pragma unroll
      for (int j = 0; j < 6; ++j) *(u32x4*)(kls + 64 * j) = kr_[j];
#pragma unroll
      for (int j = 0; j < 4; ++j) *(u32x4*)(vls + 16 * j) = vr_[j];
      __syncthreads();
      if (kt + 1 < 132) {
        kptr += 64 * 3072; vptr += 64;
#pragma unroll
        for (int j = 0; j < 6; ++j) kr_[j] = *(const u32x4*)(kptr + 32 * j);
#pragma unroll
        for (int j = 0; j < 4; ++j) vr_[j] = *(const u32x4*)(vptr + 8 * j);
      }
      if (kt == 4) {
#pragma unroll
        for (int ds = 0; ds < 4; ++ds) qf[8 + ds] = *(const bf16x8*)(qp + 128 + 16 * ds + 8 * h);
      }
      f32x16 St[2];
      __builtin_amdgcn_s_setprio(1);
#pragma unroll
      for (int kb = 0; kb < 2; ++kb) {
#pragma unroll
        for (int i = 0; i < 16; ++i) St[kb][i] = 0.f;
#pragma unroll
        for (int ds = 0; ds < 12; ++ds) {
          const bf16x8 kf = *(const bf16x8*)(Ks + (32 * kb + ksr) * KROW + (16 * ds + 8 * h) * 2);
          St[kb] = MFMA(kf, qf[ds], St[kb]);
          if ((ds & 3) == 3) __builtin_amdgcn_sched_barrier(0);
        }
      }
      __builtin_amdgcn_s_setprio(0);
      asm volatile("s_nop 7\n\ts_nop 7" ::: "memory");
      float mx = St[0][0];
#pragma unroll
      for (int kb = 0; kb < 2; ++kb)
#pragma unroll
        for (int i = 0; i < 16; ++i) mx = fmaxf(mx, St[kb][i]);
      mx = fmaxf(mx, __shfl_xor(mx, 32));
      const float mn = fmaxf(m, mx); const float alpha = __builtin_amdgcn_exp2f(m - mn); m = mn;
      St[0] = St[0] - mn; St[1] = St[1] - mn;
#pragma unroll
      for (int kb = 0; kb < 2; ++kb)
#pragma unroll
        for (int i = 0; i < 16; ++i) St[kb][i] = __builtin_amdgcn_exp2f(St[kb][i]);
      float ls;
      { const f32x16 t = St[0] + St[1];
        const f32x4 a = (f32x4){t[0], t[1], t[2], t[3]} + (f32x4){t[4], t[5], t[6], t[7]} + (f32x4){t[8], t[9], t[10], t[11]} + (f32x4){t[12], t[13], t[14], t[15]};
        ls = (a[0] + a[1]) + (a[2] + a[3]); }
      l = l * alpha + ls;
      if (__builtin_amdgcn_ballot_w64(alpha != 1.0f) != 0ull) {
#pragma unroll
        for (int di = 0; di < 4; ++di)
#pragma unroll
          for (int i = 0; i < 16; ++i) O[di][i] *= alpha;
      }
      __builtin_amdgcn_s_setprio(1);
#pragma unroll
      for (int kb = 0; kb < 2; ++kb)
#pragma unroll
        for (int s = 0; s < 2; ++s) {
          u32x4 pk;
#pragma unroll
          for (int e = 0; e < 4; ++e) pk[e] = pack2bf(St[kb][8 * s + 2 * e], St[kb][8 * s + 2 * e + 1]);
          const bf16x8 pf = __builtin_bit_cast(bf16x8, pk);
#pragma unroll
          for (int di = 0; di < 4; ++di) {
            const bf16x8 vf = *(const bf16x8*)(Vs + (32 * di + r) * LROW + (32 * kb + 16 * s + 8 * h) * 2);
            O[di] = MFMA(vf, pf, O[di]);
          }
          __builtin_amdgcn_sched_barrier(0);
        }
      __builtin_amdgcn_s_setprio(0);
      asm volatile("s_nop 7\n\ts_nop 7" ::: "memory");
    }
    l += __shfl_xor(l, 32);
    const float inv = 1.0f / l;
    const int grow = g * 16384 + lq;
    u16* op = SZ + (size_t)grow * 2048 + head * 128;
    if (dry && l > 0.f) continue;
#pragma unroll
    for (int di = 0; di < 4; ++di)
#pragma unroll
      for (int q = 0; q < 4; ++q) {
        const int n = 32 * di + 8 * q + 4 * h;
        const u32x2 z = *(const u32x2*)(op + n);
        *(u32x2*)(op + n) = (u32x2){pack2bf(O[di][4 * q] * inv * bflo(z[0]), O[di][4 * q + 1] * inv * bfhi(z[0])), pack2bf(O[di][4 * q + 2] * inv * bflo(z[1]), O[di][4 * q + 3] * inv * bfhi(z[1]))};
      }
  }
}

typedef const volatile __attribute__((address_space(4))) unsigned long long* kargp_t;
DI Params ldp() {
  kargp_t kp = (kargp_t)__builtin_amdgcn_kernarg_segment_ptr();
  Params q;
  q.x = (const float*)(const __attribute__((address_space(1))) float*)kp[0];
  q.c = (const float*)(const __attribute__((address_space(1))) float*)kp[1];
  q.ctx = (const float*)(const __attribute__((address_space(1))) float*)kp[2];
  q.c_ctx = (const float*)(const __attribute__((address_space(1))) float*)kp[3];
  q.ada_w = (const float*)(const __attribute__((address_space(1))) float*)kp[4];
  q.ada_b = (const float*)(const __attribute__((address_space(1))) float*)kp[5];
  q.sgu_w_in = (const float*)(const __attribute__((address_space(1))) float*)kp[6];
  q.sgu_gain = (const float*)(const __attribute__((address_space(1))) float*)kp[7];
  q.sgu_w_s = (const float*)(const __attribute__((address_space(1))) float*)kp[8];
  q.sgu_b_s = (const float*)(const __attribute__((address_space(1))) float*)kp[9];
  q.sgu_w_out = (const float*)(const __attribute__((address_space(1))) float*)kp[10];
  q.rwkv_mu = (const float*)(const __attribute__((address_space(1))) float*)kp[11];
  q.rwkv_w_in = (const float*)(const __attribute__((address_space(1))) float*)kp[12];
  q.rwkv_w_lora1 = (const float*)(const __attribute__((address_space(1))) float*)kp[13];
  q.rwkv_w_lora2 = (const float*)(const __attribute__((address_space(1))) float*)kp[14];
  q.rwkv_w0 = (const float*)(const __attribute__((address_space(1))) float*)kp[15];
  q.rwkv_a_lora1 = (const float*)(const __attribute__((address_space(1))) float*)kp[16];
  q.rwkv_a_lora2 = (const float*)(const __attribute__((address_space(1))) float*)kp[17];
  q.rwkv_a0 = (const float*)(const __attribute__((address_space(1))) float*)kp[18];
  q.rwkv_k_k = (const float*)(const __attribute__((address_space(1))) float*)kp[19];
  q.rwkv_k_a = (const float*)(const __attribute__((address_space(1))) float*)kp[20];
  q.rwkv_r_k = (const float*)(const __attribute__((address_space(1))) float*)kp[21];
  q.rwkv_ln_gain = (const float*)(const __attribute__((address_space(1))) float*)kp[22];
  q.rwkv_ln_bias = (const float*)(const __attribute__((address_space(1))) float*)kp[23];
  q.rwkv_w_out = (const float*)(const __attribute__((address_space(1))) float*)kp[24];
  q.mla_w_in = (const float*)(const __attribute__((address_space(1))) float*)kp[25];
  q.mla_q_norm = (const float*)(const __attribute__((address_space(1))) float*)kp[26];
  q.mla_kv_norm = (const float*)(const __attribute__((address_space(1))) float*)kp[27];
  q.mla_w_uq = (const float*)(const __attribute__((address_space(1))) float*)kp[28];
  q.mla_w_ukv = (const float*)(const __attribute__((address_space(1))) float*)kp[29];
  q.mla_qk_gain_q = (const float*)(const __attribute__((address_space(1))) float*)kp[30];
  q.mla_qk_gain_k = (const float*)(const __attribute__((address_space(1))) float*)kp[31];
  q.mla_w_out = (const float*)(const __attribute__((address_space(1))) float*)kp[32];
  q.out = (float*)(__attribute__((address_space(1))) float*)kp[33];
  q.ws = (char*)(__attribute__((address_space(1))) char*)kp[34];
  return q;
}

#define XB_TMO      128
#define XB_XCNT(j)  (256  + 64 * (j))
#define XB_XSUB(j)  (1280 + 64 * (j))
#define XB_XGEN(j)  (2304 + 64 * (j))
#define XB_TOP      3328
#define XB_TOPGEN   3392
#define XCD_BAR_WORDS 3456
#define XB_SPIN_CAP (1u << 18)
#define LAS __attribute__((address_space(3)))
DI unsigned xb_ld(unsigned* p)              { return __hip_atomic_load(p, __ATOMIC_RELAXED, __HIP_MEMORY_SCOPE_AGENT); }
DI unsigned xb_add(unsigned* p, unsigned v) { return __hip_atomic_fetch_add(p, v, __ATOMIC_RELAXED, __HIP_MEMORY_SCOPE_AGENT); }
DI unsigned xb_xcc_id() { return (unsigned)__builtin_amdgcn_s_getreg((3 << 11) | 20) & 0xFu; }
#define XB_SPIN(cond, bar) do { unsigned _sp = 0; while (cond) { __builtin_amdgcn_s_sleep(1); \
    if ((++_sp & 255u) == 0u) { if (xb_ld(&(bar)[XB_TMO])) break; if (_sp > XB_SPIN_CAP) { atomicAdd(&(bar)[XB_TMO], 1u); break; } } } } while (0)
struct XcdBarrier { unsigned* bar; unsigned x; volatile LAS unsigned* st; };
DI XcdBarrier xcd_barrier_post(unsigned* bar, volatile LAS unsigned* st) {
  XcdBarrier b; b.bar = bar; b.x = xb_xcc_id(); b.st = st;
  if (threadIdx.x == 0) (void)xb_add(&bar[XB_XCNT(b.x)], 1u);
  return b;
}
DI void xcd_barrier_complete(unsigned* bar, unsigned x, unsigned& nloc, unsigned& nx) {
  const unsigned G = gridDim.x * gridDim.y * gridDim.z;
  unsigned sum, cnt, mine, sp = 0u;
  for (;;) {
    sum = 0u; cnt = 0u; mine = 0u;
#pragma unroll
    for (unsigned j = 0; j < 16; ++j) { const unsigned c = xb_ld(&bar[XB_XCNT(j)]); sum += c; cnt += (c > 0u) ? 1u : 0u; mine = (j == x) ? c : mine; }
    if (sum == G) break;
    __builtin_amdgcn_s_sleep(1);
    if ((++sp & 255u) == 0u) { if (xb_ld(&bar[XB_TMO])) break; if (sp > XB_SPIN_CAP) { atomicAdd(&bar[XB_TMO], 1u); break; } }
  }
  nloc = mine > 0u ? mine : 1u; nx = cnt > 0u ? cnt : 1u;
}
DI void xcd_barrier(const XcdBarrier& b) {
  asm volatile("s_waitcnt vmcnt(0)" ::: "memory");
  __syncthreads();
  if (threadIdx.x == 0) {
    unsigned* bar = b.bar;
    __builtin_amdgcn_s_waitcnt(0);
    unsigned nloc = b.st[0], nx = b.st[1];
    if (nloc == 0u) { xcd_barrier_complete(bar, b.x, nloc, nx); b.st[0] = nloc; b.st[1] = nx; }
    const unsigned old = xb_add(&bar[XB_XSUB(b.x)], 1u);
    const unsigned gen = old / nloc;
    if (old + 1u == (gen + 1u) * nloc) {
      __builtin_amdgcn_fence(__ATOMIC_RELEASE, "agent");
      asm volatile("s_waitcnt vmcnt(0)" ::: "memory");
      const unsigned og = xb_add(&bar[XB_TOP], 1u);
      const unsigned tg = og / nx;
      if (og + 1u == (tg + 1u) * nx) xb_add(&bar[XB_TOPGEN], 1u);
      else XB_SPIN(xb_ld(&bar[XB_TOPGEN]) == tg, bar);
      __builtin_amdgcn_fence(__ATOMIC_ACQUIRE, "agent");
      xb_add(&bar[XB_XGEN(b.x)], 1u);
      asm volatile("s_waitcnt vmcnt(0)" ::: "memory");
    } else {
      XB_SPIN(xb_ld(&bar[XB_XGEN(b.x)]) == gen, bar);
      __builtin_amdgcn_fence(__ATOMIC_ACQUIRE, "agent");
      asm volatile("s_waitcnt vmcnt(0)" ::: "memory");
    }
  }
  __syncthreads();
}

#ifndef ONLY_PH
#define ONLY_PH -1
#endif
#ifndef SKIP_PH
#define SKIP_PH -2
#endif
#ifndef SKIP_PH2
#define SKIP_PH2 -2
#endif
#ifndef PROBE
#define PROBE 0
#endif
#define PH(n) ((ONLY_PH < 0 || ONLY_PH == (n)) && SKIP_PH != (n) && SKIP_PH2 != (n))
__global__ void __launch_bounds__(NTHREADS, LB2) mega(Params p) {
  __shared__ __attribute__((aligned(16))) char smem[SMEM_BYTES];
  cg::grid_group grid = cg::this_grid();
  __shared__ uint4 xb_words;
  if (threadIdx.x == 0) xb_words = make_uint4(0u, 0u, 0u, 0u);
  __syncthreads();
  const XcdBarrier xb = xcd_barrier_post((unsigned*)(p.ws + OFF_BAR), (volatile LAS unsigned*)&xb_words);
  if (PH(0)) { const Params q = ldp(); const u16* W = (const u16*)(q.ws + OFF_W); (void)W; phase_prologue(q, smem); }
  if (p.out == nullptr) grid.sync();
  xcd_barrier(xb);
  if (PH(1)) { const Params q = ldp(); const u16* W = (const u16*)(q.ws + OFF_W); (void)W; phase_norm(q, 0, MALL); }
  xcd_barrier(xb);
  if (PROBE & 32) { const Params q = ldp(); phase_sgu_g1_dry(q, MALL, smem); xcd_barrier(xb); }
  if (PH(2)) { const Params q = ldp(); const u16* W = (const u16*)(q.ws + OFF_W); (void)W; phase_sgu_g1(q, 0, MALL, smem); }
  xcd_barrier(xb);
  if (PH(3)) { const Params q = ldp(); const u16* W = (const u16*)(q.ws + OFF_W); (void)W; phase_sgu_mix(q, 0, MALL, smem); }
  xcd_barrier(xb);
  if (PH(4)) { const Params q = ldp(); const u16* W = (const u16*)(q.ws + OFF_W); (void)W; phase_outproj(q, 0, (const u16*)(q.ws + OFF_GUZ), 2048, W + W_SGUOUT, MALL, smem); }
  xcd_barrier(xb);
  if (PH(5)) { const Params q = ldp(); const u16* W = (const u16*)(q.ws + OFF_W); (void)W; phase_norm(q, 1, MALL); }
  xcd_barrier(xb);
  if (PROBE & 4) { const Params q = ldp(); phase_rwkv_g(q, smem); xcd_barrier(xb); }
  if (PH(6)) { const Params q = ldp(); const u16* W = (const u16*)(q.ws + OFF_W); (void)W; phase_rwkv_g(q, smem); }
  xcd_barrier(xb);
  if (PROBE & 2) { const Params q = ldp(); phase_scan_seq(q, smem); xcd_barrier(xb); }
  if (PH(7)) { const Params q = ldp(); phase_scan_seq(q, smem); }
  xcd_barrier(xb);
  if (PH(10)) { const Params q = ldp(); const u16* W = (const u16*)(q.ws + OFF_W); (void)W; phase_rwkv_ln(q); }
  xcd_barrier(xb);
  if (PH(11)) { const Params q = ldp(); const u16* W = (const u16*)(q.ws + OFF_W); (void)W; phase_outproj(q, 1, (const u16*)(q.ws + OFF_Z), 1024, W + W_ROUT, MALL, smem); }
  xcd_barrier(xb);
  if (PH(12)) { const Params q = ldp(); const u16* W = (const u16*)(q.ws + OFF_W); (void)W; phase_norm(q, 2, MALL); }
  xcd_barrier(xb);
  if (PH(13)) { const Params q = ldp(); const u16* W = (const u16*)(q.ws + OFF_W); (void)W; phase_mla_in(q, smem); }
  xcd_barrier(xb);
#pragma unroll 1
  for (int g = 0; g < 4; ++g) {
    if (PROBE & 8) { const Params q = ldp(); phase_mla_up(q, g, smem); xcd_barrier(xb); }
    if (PH(14)) { const Params q = ldp(); const u16* W = (const u16*)(q.ws + OFF_W); (void)W; phase_mla_up(q, g, smem); }
    xcd_barrier(xb);
    if (PROBE & 1) { const Params q = ldp(); phase_attn(q, g, smem, true); xcd_barrier(xb); }
    if (PH(15)) { const Params q = ldp(); const u16* W = (const u16*)(q.ws + OFF_W); (void)W; phase_attn(q, g, smem); }
    xcd_barrier(xb);
  }
  if (PH(22)) { const Params q = ldp(); const u16* W = (const u16*)(q.ws + OFF_W); (void)W; phase_outproj(q, 2, (const u16*)(q.ws + OFF_SZ), 2048, W + W_MOUT, T, smem); }
  xcd_barrier(xb);
  if (PH(23)) { const Params q = ldp(); const u16* W = (const u16*)(q.ws + OFF_W); (void)W; phase_norm(q, 3, T); }
  xcd_barrier(xb);
  if (PH(24)) { const Params q = ldp(); const u16* W = (const u16*)(q.ws + OFF_W); (void)W; phase_sgu_g1(q, 3, T, smem); }
  xcd_barrier(xb);
  if (PH(25)) { const Params q = ldp(); const u16* W = (const u16*)(q.ws + OFF_W); (void)W; phase_sgu_mix(q, 3, T, smem); }
  xcd_barrier(xb);
  if (PH(26)) { const Params q = ldp(); const u16* W = (const u16*)(q.ws + OFF_W); (void)W; phase_outproj(q, 3, (const u16*)(q.ws + OFF_GUZ), 2048, W + W_SGUOUT + 1024ull * 2048, T, smem); }
}

extern "C" void kernel_launch(void* const* d_in, const int* in_sizes, int n_in, void* d_out, int out_size, void* d_ws, size_t ws_size, hipStream_t stream) {
  static int grid_blocks = 0;
  if (!grid_blocks) {
    int dev = 0, cus = 0, per_cu = 0;
    hipGetDevice(&dev);
    hipDeviceGetAttribute(&cus, hipDeviceAttributeMultiprocessorCount, dev);
    hipOccupancyMaxActiveBlocksPerMultiprocessor(&per_cu, mega, NTHREADS, 0);
    if (per_cu > 2) per_cu = 2;
    if (per_cu < 1) per_cu = 1;
    grid_blocks = cus * per_cu;
  }
  Params p{};
  const float** f = (const float**)&p;
  for (int i = 0; i < 33; ++i) f[i] = (const float*)d_in[i];
  p.out = (float*)d_out;
  p.ws = (char*)d_ws;
  hipMemsetAsync((char*)d_ws + OFF_BAR, 0, XCD_BAR_WORDS * 4, stream);
  void* args[] = {&p};
  hipError_t e = hipLaunchCooperativeKernel((void*)mega, dim3(grid_blocks), dim3(NTHREADS), args, 0, stream);
  if (e != hipSuccess) fprintf(stderr, "cooperative launch failed: %s (grid %d)\n", hipGetErrorString(e), grid_blocks);
}
```
